# Optimizing an MI355X kernel written in HIP

```python
import jax, jax.numpy as jnp
from jax import lax
import numpy as np

D_MODEL = 1024
BATCH = 4
SEQ = 4096
DEPTH = 4

CONV_WIDTH = D_MODEL
CONV_K = 3
N_Q_HEADS = 16
N_KV_HEADS = 4
HEAD_DIM = 64
ATTN_WIDTH = N_Q_HEADS * HEAD_DIM
KV_WIDTH = N_KV_HEADS * HEAD_DIM
WINDOW = 128
BLOCK = 128
N_BRANCHES = 2
EPS = 1e-6
NEG_INF = -1e30

IN_SIZES = (CONV_WIDTH, CONV_WIDTH, CONV_WIDTH, CONV_WIDTH,
            ATTN_WIDTH, KV_WIDTH, KV_WIDTH, ATTN_WIDTH,
            N_BRANCHES * D_MODEL)
IN_COLS = sum(IN_SIZES)
SPLIT_POINTS = tuple(int(c) for c in np.cumsum(IN_SIZES)[:-1])

kernel_name = "hybrid_shortconv_swa_sink_gated_block"


def rms_norm(x, g):
    xf = x.astype(jnp.float32)
    y = xf * lax.rsqrt(jnp.mean(xf * xf, axis=-1, keepdims=True) + EPS)
    return (y * g.astype(jnp.float32)).astype(x.dtype)


def causal_depthwise_conv(u, w):
    s = u.shape[1]
    up = jnp.pad(u, ((0, 0), (CONV_K - 1, 0), (0, 0)))
    y = up[:, 0:s] * w[0]
    for k in range(1, CONV_K):
        y = y + up[:, k:k + s] * w[k]
    return y


def sliding_window_attention(q, k, v, sinks):
    b, s = q.shape[0], q.shape[1]
    nb = s // BLOCK
    g = N_Q_HEADS // N_KV_HEADS
    qb = q.reshape(b, nb, BLOCK, N_KV_HEADS, g, HEAD_DIM)

    def band(t):
        tb = t.reshape(b, nb, BLOCK, N_KV_HEADS, HEAD_DIM)
        prev = jnp.pad(tb[:, :-1], ((0, 0), (1, 0), (0, 0), (0, 0), (0, 0)))
        return jnp.concatenate([prev, tb], axis=2)

    kb, vb = band(k), band(v)
    scale = HEAD_DIM ** -0.5
    scores = jnp.einsum('bnqhgd,bnkhd->bnhgqk', qb.astype(jnp.float32),
                        kb.astype(jnp.float32)) * scale
    blk = jnp.arange(nb)[:, None, None]
    q_pos = blk * BLOCK + jnp.arange(BLOCK)[None, :, None]
    k_pos = (blk - 1) * BLOCK + jnp.arange(2 * BLOCK)[None, None, :]
    diff = q_pos - k_pos
    valid = (diff >= 0) & (diff < WINDOW) & (k_pos >= 0)
    scores = jnp.where(valid[None, :, None, None], scores, NEG_INF)
    sink = sinks.astype(jnp.float32).reshape(N_KV_HEADS, g)[None, None, :, :, None, None]
    m = jnp.maximum(jnp.max(scores, axis=-1, keepdims=True), sink)
    p = jnp.exp(scores - m)
    p = p / (jnp.sum(p, axis=-1, keepdims=True) + jnp.exp(sink - m))
    out = jnp.einsum('bnhgqk,bnkhd->bnqhgd', p.astype(v.dtype), vb)
    return out.reshape(b, s, ATTN_WIDTH)


def hybrid_layer(x, norm_g, w_in, conv_w, q_norm_g, k_norm_g, sinks,
                 w_conv_out, w_attn_out, gate_b, w_out):
    b, s, _ = x.shape
    h = rms_norm(x, norm_g)
    u = jnp.einsum('bsd,dc->bsc', h, w_in)
    v_c, b_c, c_c, z_c, q, k, v, z_a, gate_logits = jnp.split(u, SPLIT_POINTS, axis=-1)

    y_c = b_c * causal_depthwise_conv(c_c * v_c, conv_w)
    y_c = y_c * jax.nn.silu(z_c)
    y_a = jnp.einsum('bsc,cd->bsd', y_c, w_conv_out)

    q = rms_norm(q.reshape(b, s, N_Q_HEADS, HEAD_DIM), q_norm_g)
    k = rms_norm(k.reshape(b, s, N_KV_HEADS, HEAD_DIM), k_norm_g)
    v = v.reshape(b, s, N_KV_HEADS, HEAD_DIM)
    o = sliding_window_attention(q, k, v, sinks) * jax.nn.silu(z_a)
    y_b = jnp.einsum('bsc,cd->bsd', o, w_attn_out)

    gates = jax.nn.sigmoid(gate_logits + gate_b)
    g_a, g_b = jnp.split(gates, N_BRANCHES, axis=-1)
    merged = g_a * y_a + g_b * y_b
    return x + jnp.einsum('bsd,de->bse', merged, w_out)


def setup_inputs(seed: int = 0) -> dict:
    key = jax.random.key(seed)
    ks = jax.random.split(key, 12)
    f32 = jnp.float32
    x = jax.random.normal(ks[0], (BATCH, SEQ, D_MODEL), f32)
    norm_g = 1.0 + 0.05 * jax.random.normal(ks[1], (DEPTH, D_MODEL), f32)
    w_in = jax.random.normal(ks[2], (DEPTH, D_MODEL, IN_COLS), f32) * D_MODEL ** -0.5
    conv_w = jax.random.normal(ks[3], (DEPTH, CONV_K, CONV_WIDTH), f32) * CONV_K ** -0.5
    q_norm_g = 1.0 + 0.05 * jax.random.normal(ks[4], (DEPTH, HEAD_DIM), f32)
    k_norm_g = 1.0 + 0.05 * jax.random.normal(ks[5], (DEPTH, HEAD_DIM), f32)
    sinks = 0.5 * jax.random.normal(ks[6], (DEPTH, N_Q_HEADS), f32)
    w_conv_out = jax.random.normal(ks[7], (DEPTH, CONV_WIDTH, D_MODEL), f32) * CONV_WIDTH ** -0.5
    w_attn_out = jax.random.normal(ks[8], (DEPTH, ATTN_WIDTH, D_MODEL), f32) * ATTN_WIDTH ** -0.5
    gate_b = 0.02 * jax.random.normal(ks[9], (DEPTH, N_BRANCHES * D_MODEL), f32)
    w_out = jax.random.normal(ks[10], (DEPTH, D_MODEL, D_MODEL), f32) * D_MODEL ** -0.5
    return {"x": x, "norm_g": norm_g, "w_in": w_in, "conv_w": conv_w,
            "q_norm_g": q_norm_g, "k_norm_g": k_norm_g, "sinks": sinks,
            "w_conv_out": w_conv_out, "w_attn_out": w_attn_out,
            "gate_b": gate_b, "w_out": w_out}


def reference(x, norm_g, w_in, conv_w, q_norm_g, k_norm_g, sinks,
              w_conv_out, w_attn_out, gate_b, w_out):
    for l in range(DEPTH):
        x = hybrid_layer(x, norm_g[l], w_in[l], conv_w[l], q_norm_g[l], k_norm_g[l],
                         sinks[l], w_conv_out[l], w_attn_out[l], gate_b[l], w_out[l])
    return x
```

```cpp
#include <hip/hip_runtime.h>
#include <hip/hip_cooperative_groups.h>
#include <cstdio>
#include <cstdint>
namespace cg = cooperative_groups;

#ifndef MK_ONE_LAUNCH
#define MK_ONE_LAUNCH 1
#endif

#define LAS __attribute__((address_space(3)))
typedef unsigned short bf16_t;
typedef short bf16x8 __attribute__((ext_vector_type(8)));
typedef short s16x4 __attribute__((ext_vector_type(4)));
typedef float f32x4 __attribute__((ext_vector_type(4)));
typedef unsigned u32x4 __attribute__((ext_vector_type(4)));
typedef unsigned u32x2 __attribute__((ext_vector_type(2)));

constexpr int DM = 1024, BATCH = 4, SEQ = 4096, DEPTH = 4, M = BATCH * SEQ;
constexpr int NQH = 16, NKVH = 4, HD = 64, KVW = NKVH * HD;
constexpr int NCOLS = 4 * DM + DM + 2 * KVW + DM + 2 * DM;
constexpr float EPS = 1e-6f;
constexpr float LOG2E = 1.4426950408889634f;
constexpr float QSCALE = 0.125f * LOG2E;

constexpr size_t MiB = 1u << 20;
constexpr size_t WS_ROWSS = 0;
constexpr size_t WS_W = 1 * MiB;
constexpr size_t W_LAYER = 23 * MiB, W_CO = 17 * MiB, W_AO = 19 * MiB, W_OUT = 21 * MiB;
constexpr size_t WS_XB = 96 * MiB;
constexpr size_t WS_CV = 128 * MiB;
constexpr size_t WS_Q = 256 * MiB;
constexpr size_t WS_K = 288 * MiB;
constexpr size_t WS_V = 296 * MiB;
constexpr size_t WS_SZ = 304 * MiB;
constexpr size_t WS_G = 336 * MiB;
constexpr size_t WS_YC = 400 * MiB;
constexpr size_t WS_OA = 432 * MiB;
constexpr size_t WS_MG = 464 * MiB;
constexpr size_t WS_END = 496 * MiB;

constexpr int NWAVES = 8;
constexpr int LDS_BYTES = 147456;

typedef float f32x2_t __attribute__((ext_vector_type(2))); typedef __bf16 bf16x2_t __attribute__((ext_vector_type(2)));
__device__ __forceinline__ unsigned cvt_pk_bf16(float lo, float hi) { f32x2_t v = {lo, hi}; bf16x2_t b = __builtin_convertvector(v, bf16x2_t); return __builtin_bit_cast(unsigned, b); }
__device__ __forceinline__ float bf_lo(unsigned u) { return __uint_as_float(u << 16); }
__device__ __forceinline__ float bf_hi(unsigned u) { return __uint_as_float(u & 0xffff0000u); }
__device__ __forceinline__ float fast_sigmoid(float v) { return __builtin_amdgcn_rcpf(1.0f + __builtin_amdgcn_exp2f(-v * LOG2E)); }

namespace pg8 {
constexpr int BM = 256, BK = 64, HALF = 128, HTB = HALF * BK * 2, STAGE_BYTES = 8 * HTB, NXCD = 8, WGM = 8;
__host__ __device__ __forceinline__ int lds_byte(int r, int c) { const int st = (r >> 4) * 2 + (c >> 5), rr = r & 15, cc = c & 31, ob = rr * 64 + cc * 2; return st * 1024 + (ob ^ (((ob >> 9) & 1) << 5)); }
__host__ __device__ __forceinline__ void stage_rc(int b, int& R, int& C) { const int st = b / 1024, sb = b % 1024, swz = sb ^ (((sb >> 9) & 1) << 5); R = (st >> 1) * 16 + swz / 64; C = (st & 1) * 32 + (swz % 64) / 2; }
__host__ __device__ __forceinline__ int perm32(int rho) { const int n = rho >> 4, i = rho & 15; return 8 * (i >> 2) + 4 * n + (i & 3); }

struct Unit { int pm, pn, seg; };
struct Gemm { const bf16_t* A0; const bf16_t* B0; const bf16_t* A1; const bf16_t* B1; int K; };

struct StaticOrder {
    int nM, nN, nwg, G, c, nseg;
    __device__ void init(int M_, int N_, int G_, int c_, int nseg_) { nM = M_ / BM; nN = N_ / BM; nwg = nM * nN; G = G_; c = c_; nseg = nseg_; }
    __device__ bool next(int i, Unit& u) const {
        int ti = i; u.seg = 0;
        if (nseg == 2) { ti = i >> 1; u.seg = i & 1; }
        const long L = (long)ti * G + c; if (L >= nwg) return false;
        int wgid = (int)L; { const int q = nwg / NXCD, r = nwg % NXCD, xcd = wgid % NXCD, off = wgid / NXCD; wgid = (xcd < r ? xcd * (q + 1) : r * (q + 1) + (xcd - r) * q) + off; }
        const int nig = WGM * nN, gid = wgid / nig, fm = gid * WGM, gsz = (nM - fm) < WGM ? (nM - fm) : WGM;
        u.pm = fm + ((wgid % nig) % gsz); u.pn = (wgid % nig) / gsz; return true;
    }
};

typedef f32x4 Acc[2][2][4][2];

template <class Epi, bool ALIGN_EPI, bool SP2>
__device__ __forceinline__ void gemm_phase(LAS unsigned char* lds, const int tid, const Gemm g, const StaticOrder& S, const Epi& E) {
    const int wid = __builtin_amdgcn_readfirstlane(tid >> 6), lane = tid & 63, wr = wid >> 2, wc = wid & 3, fr = lane & 15, fq = lane >> 4;
    const int K = g.K, nt = K / BK;
    unsigned voffA[2], voffB[2];
#pragma unroll
    for (int i = 0; i < 2; ++i) { int R, C; stage_rc(tid * 16 + i * 8192, R, C); const int Rb = Epi::PERM ? ((R & ~31) + perm32(R & 31)) : R;
        voffA[i] = (unsigned)(R * K + C) * 2u; voffB[i] = (unsigned)(Rb * K + C) * 2u; }
    const size_t kstep = (size_t)(BK * 2);
    const size_t hstep = (size_t)HALF * K * 2;
    const size_t tstep = 2 * hstep;
    const unsigned ldsw = (unsigned)wid * 1024u;
    const int aoff = lds_byte(wr * 64 + fr, fq * 8), boff = lds_byte(wc * 32 + fr, fq * 8);
#define PG8_SA(b, h) (((b) * 2 + (h)) * HTB)
#define PG8_SB(b, h) ((4 + (b) * 2 + (h)) * HTB)
#define PG8_STAGE(bufoff, gbase, voff) do { _Pragma("unroll") for (int _i = 0; _i < 2; ++_i) \
        __builtin_amdgcn_global_load_lds((const unsigned*)((const char*)(gbase) + (voff)[_i]), (LAS unsigned*)(lds + (bufoff) + ldsw + _i * 8192), 16, 0, 0); } while (0)
#define PG8_LDA(dst, b, h) do { _Pragma("unroll") for (int m = 0; m < 4; ++m) _Pragma("unroll") for (int k = 0; k < 2; ++k) dst[m][k] = *(const LAS bf16x8*)(lds + PG8_SA(b, h) + aoff + m * 2048 + k * 1024); } while (0)
#define PG8_LDB(dst, b, h) do { _Pragma("unroll") for (int n = 0; n < 2; ++n) _Pragma("unroll") for (int k = 0; k < 2; ++k) dst[n][k] = *(const LAS bf16x8*)(lds + PG8_SB(b, h) + boff + n * 2048 + k * 1024); } while (0)
#define PG8_MMA(ai, bj, At, Bt) do { __builtin_amdgcn_s_setprio(1); _Pragma("unroll") for (int m = 0; m < 4; ++m) _Pragma("unroll") for (int n = 0; n < 2; ++n) _Pragma("unroll") for (int k = 0; k < 2; ++k) \
        acc[ai][bj][m][n] = __builtin_amdgcn_mfma_f32_16x16x32_bf16(Bt[n][k], At[m][k], acc[ai][bj][m][n], 0, 0, 0); __builtin_amdgcn_s_setprio(0); } while (0)
#define PG8_WAIT_V(n) asm volatile("s_waitcnt vmcnt(" #n ")" ::: "memory")
#define PG8_WAIT_L(n) asm volatile("s_waitcnt lgkmcnt(" #n ")" ::: "memory")
#define PG8_BAR __builtin_amdgcn_s_barrier()
#define PG8_SCHED __builtin_amdgcn_sched_barrier(0)
    Unit cur, nxt; int ui = 0;
    if (!S.next(0, cur)) return;
    Acc acc;
#pragma unroll
    for (int a = 0; a < 2; ++a)
#pragma unroll
        for (int b = 0; b < 2; ++b)
#pragma unroll
            for (int m = 0; m < 4; ++m)
#pragma unroll
                for (int n = 0; n < 2; ++n) acc[a][b][m][n] = (f32x4){0.f, 0.f, 0.f, 0.f};
    bf16x8 At[4][2], B0[2][2], B1[2][2];
    const char* cA = (const char*)(cur.seg ? g.A1 : g.A0) + (size_t)cur.pm * tstep; const char* cB = (const char*)(cur.seg ? g.B1 : g.B0) + (size_t)cur.pn * tstep;
    if constexpr (SP2) {
        PG8_STAGE(PG8_SB(0, 0), cB, voffB); PG8_STAGE(PG8_SB(0, 1), cB + hstep, voffB); PG8_STAGE(PG8_SA(0, 0), cA, voffA); PG8_STAGE(PG8_SA(0, 1), cA + hstep, voffA);
        if (wr == 1) PG8_BAR;
        PG8_WAIT_V(2); PG8_BAR;
        PG8_STAGE(PG8_SB(1, 0), cB + kstep, voffB); PG8_STAGE(PG8_SA(1, 0), cA + kstep, voffA); PG8_STAGE(PG8_SB(1, 1), cB + hstep + kstep, voffB);
        PG8_WAIT_V(6); PG8_BAR;
    } else {
        PG8_STAGE(PG8_SB(0, 0), cB, voffB); PG8_STAGE(PG8_SA(0, 0), cA, voffA); PG8_STAGE(PG8_SB(0, 1), cB + hstep, voffB); PG8_STAGE(PG8_SA(0, 1), cA + hstep, voffA);
        if (wr == 1) PG8_BAR;
        PG8_WAIT_V(4); PG8_BAR;
        PG8_STAGE(PG8_SB(1, 0), cB + kstep, voffB); PG8_STAGE(PG8_SA(1, 0), cA + kstep, voffA); PG8_STAGE(PG8_SB(1, 1), cB + hstep + kstep, voffB);
        PG8_WAIT_V(6); PG8_BAR;
    }
    for (;;) {
        const bool has_next = S.next(ui + 1, nxt);
        const char* nA = has_next ? (const char*)(nxt.seg ? g.A1 : g.A0) + (size_t)nxt.pm * tstep : cA; const char* nB = has_next ? (const char*)(nxt.seg ? g.B1 : g.B0) + (size_t)nxt.pn * tstep : cB;
        for (int t = 0; t < nt; t += 2) {
            const bool last = (t == nt - 2);
            const char* a1 = cA + (size_t)(t + 1) * kstep;
            const char* a2 = last ? nA : cA + (size_t)(t + 2) * kstep; const char* b2 = last ? nB : cB + (size_t)(t + 2) * kstep;
            const char* a3 = a2 + kstep; const char* b3 = b2 + kstep;
            if constexpr (SP2) {
            PG8_LDB(B0, 0, 0); PG8_LDB(B1, 0, 1); PG8_SCHED; PG8_LDA(At, 0, 0); PG8_STAGE(PG8_SA(1, 1), a1 + hstep, voffA);
            PG8_WAIT_V(8); PG8_WAIT_L(0); PG8_BAR; PG8_MMA(0, 0, At, B0); PG8_MMA(0, 1, At, B1); PG8_BAR; PG8_SCHED;
            PG8_LDA(At, 0, 1); PG8_STAGE(PG8_SB(0, 0), b2, voffB); PG8_STAGE(PG8_SB(0, 1), b2 + hstep, voffB); PG8_STAGE(PG8_SA(0, 0), a2, voffA);
            PG8_WAIT_V(8); PG8_WAIT_L(0); PG8_BAR; PG8_MMA(1, 0, At, B0); PG8_MMA(1, 1, At, B1); PG8_BAR; PG8_SCHED;
            PG8_LDB(B0, 1, 0); PG8_LDB(B1, 1, 1); PG8_SCHED; PG8_LDA(At, 1, 0); PG8_STAGE(PG8_SA(0, 1), a2 + hstep, voffA);
            PG8_WAIT_V(8); PG8_WAIT_L(0); PG8_BAR; PG8_MMA(0, 0, At, B0); PG8_MMA(0, 1, At, B1); PG8_BAR; PG8_SCHED;
            PG8_LDA(At, 1, 1); PG8_STAGE(PG8_SB(1, 0), b3, voffB); PG8_STAGE(PG8_SB(1, 1), b3 + hstep, voffB); PG8_STAGE(PG8_SA(1, 0), a3, voffA);
            PG8_WAIT_V(8); PG8_WAIT_L(0); PG8_BAR; PG8_MMA(1, 0, At, B0); PG8_MMA(1, 1, At, B1); PG8_BAR; PG8_SCHED;
            } else {
            PG8_LDB(B0, 0, 0); PG8_SCHED; PG8_LDA(At, 0, 0); PG8_STAGE(PG8_SA(1, 1), a1 + hstep, voffA);
            PG8_WAIT_L(8); PG8_BAR; PG8_WAIT_L(0); PG8_MMA(0, 0, At, B0); PG8_BAR; PG8_SCHED;
            PG8_LDB(B1, 0, 1); PG8_STAGE(PG8_SB(0, 0), b2, voffB);
            PG8_BAR; PG8_WAIT_L(0); PG8_MMA(0, 1, At, B1); PG8_BAR;
            PG8_LDA(At, 0, 1); PG8_STAGE(PG8_SA(0, 0), a2, voffA);
            PG8_BAR; PG8_WAIT_L(0); PG8_MMA(1, 0, At, B0); PG8_BAR; PG8_SCHED;
            PG8_STAGE(PG8_SB(0, 1), b2 + hstep, voffB);
            PG8_WAIT_V(6); PG8_BAR; PG8_MMA(1, 1, At, B1); PG8_BAR;
            PG8_LDB(B0, 1, 0); PG8_SCHED; PG8_LDA(At, 1, 0); PG8_STAGE(PG8_SA(0, 1), a2 + hstep, voffA);
            PG8_WAIT_L(8); PG8_BAR; PG8_WAIT_L(0); PG8_MMA(0, 0, At, B0); PG8_BAR; PG8_SCHED;
            PG8_LDB(B1, 1, 1); PG8_STAGE(PG8_SB(1, 0), b3, voffB);
            PG8_BAR; PG8_WAIT_L(0); PG8_MMA(0, 1, At, B1); PG8_BAR;
            PG8_LDA(At, 1, 1); PG8_STAGE(PG8_SA(1, 0), a3, voffA);
            PG8_BAR; PG8_WAIT_L(0); PG8_MMA(1, 0, At, B0); PG8_BAR; PG8_SCHED;
            PG8_STAGE(PG8_SB(1, 1), b3 + hstep, voffB);
            PG8_WAIT_V(6); PG8_BAR; PG8_MMA(1, 1, At, B1); PG8_BAR;
            }
        }
        if constexpr (ALIGN_EPI) { if (wr == 0) PG8_BAR; }
        bool keep = false;
        if constexpr (Epi::TWO_SEG) { if (cur.seg == 0) { E.mid(acc, cur, wr, wc, fr, fq); keep = true; } else E(acc, cur, wr, wc, fr, fq); }
        else E(acc, cur, wr, wc, fr, fq);
        if (!has_next) break;
        if (!keep) {
#pragma unroll
        for (int a = 0; a < 2; ++a)
#pragma unroll
            for (int b = 0; b < 2; ++b)
#pragma unroll
                for (int m = 0; m < 4; ++m)
#pragma unroll
                    for (int n = 0; n < 2; ++n) acc[a][b][m][n] = (f32x4){0.f, 0.f, 0.f, 0.f};
        }
        cur = nxt; cA = nA; cB = nB; ++ui;
        if constexpr (ALIGN_EPI) { if (wr == 1) PG8_BAR; }
    }
    PG8_WAIT_V(0);
    if constexpr (!ALIGN_EPI) { if (wr == 0) PG8_BAR; }
    PG8_BAR;
#undef PG8_SA
#undef PG8_SB
#undef PG8_STAGE
#undef PG8_LDA
#undef PG8_LDB
#undef PG8_MMA
#undef PG8_WAIT_V
#undef PG8_WAIT_L
#undef PG8_BAR
#undef PG8_SCHED
}
}

struct EpiIn {
    static constexpr bool PERM = true, TWO_SEG = false;
    bf16_t *CV, *Q, *Kb, *Vb, *SZ, *G; const float *rowss, *qg, *kg, *gate_b;
    __device__ __forceinline__ void store8(bf16_t* p, const f32x4& v0, const f32x4& v1) const {
        u32x4 w; w.x = cvt_pk_bf16(v0[0], v0[1]); w.y = cvt_pk_bf16(v0[2], v0[3]); w.z = cvt_pk_bf16(v1[0], v1[1]); w.w = cvt_pk_bf16(v1[2], v1[3]); *(u32x4*)p = w; }
    __device__ __forceinline__ void operator()(pg8::Acc& acc, const pg8::Unit& u, int wr, int wc, int fr, int fq) const {
        const int row0 = u.pm * 256 + wr * 64 + fr; const int pn = u.pn;
        float rs[2][4];
#pragma unroll
        for (int ai = 0; ai < 2; ++ai)
#pragma unroll
            for (int m = 0; m < 4; ++m) rs[ai][m] = 1.0f / sqrtf(rowss[row0 + ai * 128 + m * 16] * (1.0f / DM) + EPS);
        if (pn < 16 || pn == 21 || (pn >= 22 && pn < 26)) {
            bf16_t* base; int ld, colt; const bool act = (pn >= 22);
            if (pn < 16) { base = CV + (size_t)(pn >> 2) * ((size_t)M * DM); ld = DM; colt = (pn & 3) * 256; }
            else if (pn == 21) { base = Vb; ld = KVW; colt = 0; }
            else { base = SZ; ld = DM; colt = (pn - 22) * 256; }
            const int col0 = colt + wc * 32 + 8 * fq;
#pragma unroll
            for (int ai = 0; ai < 2; ++ai)
#pragma unroll
                for (int m = 0; m < 4; ++m) { bf16_t* rowp = base + (size_t)(row0 + ai * 128 + m * 16) * ld + col0; const float r = rs[ai][m];
#pragma unroll
                    for (int bj = 0; bj < 2; ++bj) { f32x4 v0 = acc[ai][bj][m][0] * r, v1 = acc[ai][bj][m][1] * r;
                        if (act) {
#pragma unroll
                            for (int i = 0; i < 4; ++i) { v0[i] = v0[i] * fast_sigmoid(v0[i]); v1[i] = v1[i] * fast_sigmoid(v1[i]); } }
                        store8(rowp + bj * 128, v0, v1); } }
        } else if (pn >= 26) {
            const int colt = (pn - 26) * 256, col0 = colt + wc * 32 + 8 * fq;
            f32x4 bv[2][2];
#pragma unroll
            for (int bj = 0; bj < 2; ++bj)
#pragma unroll
                for (int n = 0; n < 2; ++n) bv[bj][n] = *(const f32x4*)(gate_b + col0 + bj * 128 + 4 * n);
#pragma unroll
            for (int ai = 0; ai < 2; ++ai)
#pragma unroll
                for (int m = 0; m < 4; ++m) { bf16_t* rowp = G + (size_t)(row0 + ai * 128 + m * 16) * (2 * DM) + col0; const float r = rs[ai][m];
#pragma unroll
                    for (int bj = 0; bj < 2; ++bj) { f32x4 v0 = acc[ai][bj][m][0] * r + bv[bj][0], v1 = acc[ai][bj][m][1] * r + bv[bj][1];
#pragma unroll
                        for (int i = 0; i < 4; ++i) { v0[i] = fast_sigmoid(v0[i]); v1[i] = fast_sigmoid(v1[i]); }
                        store8(rowp + bj * 128, v0, v1); } }
        } else {
            const bool isq = pn < 20; bf16_t* base = isq ? Q : Kb; const int ld = isq ? DM : KVW, colt = isq ? (pn - 16) * 256 : 0;
            const float* gp = isq ? qg : kg; const float sc = isq ? QSCALE : 1.0f;
            f32x4 gv[2][2];
#pragma unroll
            for (int bj = 0; bj < 2; ++bj)
#pragma unroll
                for (int n = 0; n < 2; ++n) gv[bj][n] = *(const f32x4*)(gp + 32 * bj + 8 * fq + 4 * n) * sc;
            const int col0 = colt + wc * 64 + 8 * fq;
#pragma unroll
            for (int ai = 0; ai < 2; ++ai)
#pragma unroll
                for (int m = 0; m < 4; ++m) { bf16_t* rowp = base + (size_t)(row0 + ai * 128 + m * 16) * ld + col0; const float r = rs[ai][m];
                    f32x4 v[2][2]; float ss = 0.f;
#pragma unroll
                    for (int bj = 0; bj < 2; ++bj)
#pragma unroll
                        for (int n = 0; n < 2; ++n) { v[bj][n] = acc[ai][bj][m][n] * r; ss += (v[bj][n][0] * v[bj][n][0] + v[bj][n][1] * v[bj][n][1]) + (v[bj][n][2] * v[bj][n][2] + v[bj][n][3] * v[bj][n][3]); }
                    ss += __shfl_xor(ss, 16); ss += __shfl_xor(ss, 32);
                    const float rq = 1.0f / sqrtf(ss * (1.0f / HD) + EPS);
#pragma unroll
                    for (int bj = 0; bj < 2; ++bj) store8(rowp + bj * 32, v[bj][0] * rq * gv[bj][0], v[bj][1] * rq * gv[bj][1]); }
        }
    }
};

struct EpiMerge {
    static constexpr bool PERM = true, TWO_SEG = true;
    const bf16_t* G; bf16_t* MG;
    __device__ __forceinline__ void mid(pg8::Acc& acc, const pg8::Unit& u, int wr, int wc, int fr, int fq) const {
        const int row0 = u.pm * 256 + wr * 64 + fr, col0 = u.pn * 256 + wc * 32 + 8 * fq;
#pragma unroll
        for (int ai = 0; ai < 2; ++ai)
#pragma unroll
            for (int m = 0; m < 4; ++m) { const bf16_t* gp = G + (size_t)(row0 + ai * 128 + m * 16) * (2 * DM) + col0;
#pragma unroll
                for (int bj = 0; bj < 2; ++bj) { const u32x4 a = *(const u32x4*)(gp + bj * 128), b = *(const u32x4*)(gp + DM + bj * 128);
#pragma unroll
                    for (int j = 0; j < 4; ++j) { const float r0 = bf_lo(a[j]) * __builtin_amdgcn_rcpf(fmaxf(bf_lo(b[j]), 1e-30f)), r1 = bf_hi(a[j]) * __builtin_amdgcn_rcpf(fmaxf(bf_hi(b[j]), 1e-30f));
                        acc[ai][bj][m][j >> 1][(j & 1) * 2] *= r0; acc[ai][bj][m][j >> 1][(j & 1) * 2 + 1] *= r1; } } }
    }
    __device__ __forceinline__ void operator()(pg8::Acc& acc, const pg8::Unit& u, int wr, int wc, int fr, int fq) const {
        const int row0 = u.pm * 256 + wr * 64 + fr, col0 = u.pn * 256 + wc * 32 + 8 * fq;
#pragma unroll
        for (int ai = 0; ai < 2; ++ai)
#pragma unroll
            for (int m = 0; m < 4; ++m) { const size_t ro = (size_t)(row0 + ai * 128 + m * 16); const bf16_t* gp = G + ro * (2 * DM) + DM + col0; bf16_t* op = MG + ro * DM + col0;
#pragma unroll
                for (int bj = 0; bj < 2; ++bj) { const u32x4 b = *(const u32x4*)(gp + bj * 128); u32x4 w;
#pragma unroll
                    for (int j = 0; j < 4; ++j) w[j] = cvt_pk_bf16(acc[ai][bj][m][j >> 1][(j & 1) * 2] * bf_lo(b[j]), acc[ai][bj][m][j >> 1][(j & 1) * 2 + 1] * bf_hi(b[j]));
                    *(u32x4*)(op + bj * 128) = w; } }
    }
};

struct EpiOut {
    static constexpr bool PERM = false, TWO_SEG = false;
    const float* xin; float* xout; bf16_t* XB; float* rowss_next;
    __device__ __forceinline__ void operator()(pg8::Acc& acc, const pg8::Unit& u, int wr, int wc, int fr, int fq) const {
        const int row0 = u.pm * 256 + wr * 64 + fr, col0 = u.pn * 256 + wc * 32 + 4 * fq;
#pragma unroll
        for (int ai = 0; ai < 2; ++ai)
#pragma unroll
            for (int m = 0; m < 4; ++m) { const size_t off = (size_t)(row0 + ai * 128 + m * 16) * DM + col0; float ss = 0.f;
#pragma unroll
                for (int bj = 0; bj < 2; ++bj)
#pragma unroll
                    for (int n = 0; n < 2; ++n) { const f32x4 xv = *(const f32x4*)(xin + off + bj * 128 + n * 16); const f32x4 o = xv + acc[ai][bj][m][n];
                        *(f32x4*)(xout + off + bj * 128 + n * 16) = o; ss += (o[0] * o[0] + o[1] * o[1]) + (o[2] * o[2] + o[3] * o[3]);
                        if (rowss_next) { u32x2 w; w.x = cvt_pk_bf16(o[0], o[1]); w.y = cvt_pk_bf16(o[2], o[3]); *(u32x2*)(XB + off + bj * 128 + n * 16) = w; } }
                if (rowss_next) { ss += __shfl_xor(ss, 16); ss += __shfl_xor(ss, 32); if (fq == 0) atomicAdd(rowss_next + row0 + ai * 128 + m * 16, ss); } }
    }
};

struct Frame {
    LAS unsigned char* lds; int tid, lane, wave, vcu, G, bx;
    const float *x, *norm_g, *w_in, *conv_w, *qng, *kng, *sinks, *w_co, *w_ao, *gate_b, *w_out; float* out; unsigned char* ws;
};
__device__ __forceinline__ float wave_sum(float v) {
#pragma unroll
    for (int o = 1; o < 64; o <<= 1) v += __shfl_xor(v, o);
    return v;
}
__device__ __forceinline__ void p0_transpose_item(const float* W, int K, int N, bf16_t* WT, const float* gk, int plo, int phi, LAS float* scr, int item, int lane) {
    const int nblk = N / 32, kb = item / nblk, nb = item % nblk, k0 = 64 * kb, n0 = 32 * nb;
#pragma unroll 8
    for (int i = 0; i < 32; ++i) { const int kk = 2 * i + (lane >> 5); float w = W[(size_t)(k0 + kk) * N + n0 + (lane & 31)]; if (gk) w *= gk[k0 + kk]; scr[kk * 33 + (lane & 31)] = w; }
    asm volatile("s_waitcnt lgkmcnt(0)" ::: "memory");
    int d0 = n0;
    if (n0 >= plo && n0 < phi) { const int t = n0 & 255, wc_ = t >> 6, bj_ = (t >> 5) & 1; d0 = (n0 & ~255) + 128 * bj_ + 32 * wc_; }
    const int c = lane & 7;
#pragma unroll
    for (int j = 0; j < 4; ++j) { const int n = (lane >> 3) + 8 * j; const LAS float* s = scr + (8 * c) * 33 + n;
        u32x4 o; o.x = cvt_pk_bf16(s[0 * 33], s[1 * 33]); o.y = cvt_pk_bf16(s[2 * 33], s[3 * 33]); o.z = cvt_pk_bf16(s[4 * 33], s[5 * 33]); o.w = cvt_pk_bf16(s[6 * 33], s[7 * 33]);
        *(u32x4*)(WT + (size_t)(d0 + n) * K + k0 + 8 * c) = o; }
    asm volatile("s_waitcnt lgkmcnt(0)" ::: "memory");
}
__device__ __forceinline__ void p0_prologue(Frame& F) {
    LAS float* scr = (LAS float*)(F.lds + F.wave * 16384);
    const int gw = F.vcu * NWAVES + F.wave, NGW = F.G * NWAVES;
    constexpr int I_IN = (DM / 64) * (NCOLS / 32), I_SQ = (DM / 64) * (DM / 32), I_L = I_IN + 3 * I_SQ;
    for (int it = gw; it < DEPTH * I_L; it += NGW) {
        const int l = it / I_L; int r = it - l * I_L;
        unsigned char* wl = F.ws + WS_W + (size_t)l * W_LAYER;
        if (r < I_IN) { p0_transpose_item(F.w_in + (size_t)l * DM * NCOLS, DM, NCOLS, (bf16_t*)wl, F.norm_g + l * DM, 4 * DM, 4 * DM + DM + KVW, scr, r, F.lane); continue; } r -= I_IN;
        if (r < I_SQ) { p0_transpose_item(F.w_co + (size_t)l * DM * DM, DM, DM, (bf16_t*)(wl + W_CO), nullptr, 0, 0, scr, r, F.lane); continue; } r -= I_SQ;
        if (r < I_SQ) { p0_transpose_item(F.w_ao + (size_t)l * DM * DM, DM, DM, (bf16_t*)(wl + W_AO), nullptr, 0, 0, scr, r, F.lane); continue; } r -= I_SQ;
        p0_transpose_item(F.w_out + (size_t)l * DM * DM, DM, DM, (bf16_t*)(wl + W_OUT), nullptr, 0, 0, scr, r, F.lane);
    }
    float* rowss = (float*)(F.ws + WS_ROWSS); bf16_t* XB = (bf16_t*)(F.ws + WS_XB);
    for (int m = gw; m < M; m += NGW) {
        const f32x4* xr = (const f32x4*)(F.x + (size_t)m * DM) + F.lane; f32x4 v[4]; float s = 0.f;
#pragma unroll
        for (int j = 0; j < 4; ++j) { v[j] = xr[64 * j]; s += (v[j].x * v[j].x + v[j].y * v[j].y) + (v[j].z * v[j].z + v[j].w * v[j].w); }
        s = wave_sum(s);
        u32x2* o8 = (u32x2*)(XB + (size_t)m * DM) + F.lane;
#pragma unroll
        for (int j = 0; j < 4; ++j) { u32x2 w; w.x = cvt_pk_bf16(v[j].x, v[j].y); w.y = cvt_pk_bf16(v[j].z, v[j].w); o8[64 * j] = w; }
        if (F.lane == 0) rowss[m] = s;
        if (F.lane >= 1 && F.lane < DEPTH) rowss[(size_t)F.lane * M + m] = 0.f;
    }
}

__device__ __forceinline__ void conv_phase(Frame& F, int l) {
    const bf16_t* CVv = (const bf16_t*)(F.ws + WS_CV); const bf16_t* CVb = CVv + (size_t)M * DM; const bf16_t* CVc = CVb + (size_t)M * DM; const bf16_t* CVz = CVc + (size_t)M * DM;
    bf16_t* YC = (bf16_t*)(F.ws + WS_YC);
    const int cg8 = F.tid & 127, sub = F.tid >> 7;
    const float* cw = F.conv_w + (size_t)l * 3 * DM + cg8 * 8;
    float w0[8], w1[8], w2[8];
#pragma unroll
    for (int j = 0; j < 8; ++j) { w0[j] = cw[j]; w1[j] = cw[DM + j]; w2[j] = cw[2 * DM + j]; }
    for (int it = F.vcu; it < M / 64; it += F.G) {
        const int t0 = it * 64 + sub * 16; const size_t o0 = (size_t)t0 * DM + cg8 * 8;
        float p2[8], p1[8];
        if ((t0 & (SEQ - 1)) == 0) {
#pragma unroll
            for (int j = 0; j < 8; ++j) { p2[j] = 0.f; p1[j] = 0.f; }
        } else {
            const u32x4 va = *(const u32x4*)(CVv + o0 - 2 * DM), ca = *(const u32x4*)(CVc + o0 - 2 * DM), vb = *(const u32x4*)(CVv + o0 - DM), cb = *(const u32x4*)(CVc + o0 - DM);
#pragma unroll
            for (int j = 0; j < 4; ++j) { p2[2 * j] = bf_lo(va[j]) * bf_lo(ca[j]); p2[2 * j + 1] = bf_hi(va[j]) * bf_hi(ca[j]); p1[2 * j] = bf_lo(vb[j]) * bf_lo(cb[j]); p1[2 * j + 1] = bf_hi(vb[j]) * bf_hi(cb[j]); }
        }
#pragma unroll 4
        for (int t = 0; t < 16; ++t) {
            const size_t o = o0 + (size_t)t * DM;
            const u32x4 vv = *(const u32x4*)(CVv + o), cc = *(const u32x4*)(CVc + o), bb = *(const u32x4*)(CVb + o), zz = *(const u32x4*)(CVz + o);
            float y[8];
#pragma unroll
            for (int j = 0; j < 4; ++j) {
                const float c0 = bf_lo(vv[j]) * bf_lo(cc[j]), c1 = bf_hi(vv[j]) * bf_hi(cc[j]);
                const float z0 = bf_lo(zz[j]), z1 = bf_hi(zz[j]);
                y[2 * j] = bf_lo(bb[j]) * (w0[2 * j] * p2[2 * j] + w1[2 * j] * p1[2 * j] + w2[2 * j] * c0) * (z0 * fast_sigmoid(z0));
                y[2 * j + 1] = bf_hi(bb[j]) * (w0[2 * j + 1] * p2[2 * j + 1] + w1[2 * j + 1] * p1[2 * j + 1] + w2[2 * j + 1] * c1) * (z1 * fast_sigmoid(z1));
                p2[2 * j] = p1[2 * j]; p2[2 * j + 1] = p1[2 * j + 1]; p1[2 * j] = c0; p1[2 * j + 1] = c1;
            }
            u32x4 w; w.x = cvt_pk_bf16(y[0], y[1]); w.y = cvt_pk_bf16(y[2], y[3]); w.z = cvt_pk_bf16(y[4], y[5]); w.w = cvt_pk_bf16(y[6], y[7]);
            *(u32x4*)(YC + o) = w;
        }
    }
}

constexpr int KV_STRIDE = 160, KV_IMG = 256 * KV_STRIDE;
__device__ __forceinline__ void attn_phase(Frame& F, int l) {
    const bf16_t* Qg = (const bf16_t*)(F.ws + WS_Q); const bf16_t* Kg = (const bf16_t*)(F.ws + WS_K); const bf16_t* Vg = (const bf16_t*)(F.ws + WS_V);
    const bf16_t* SZ = (const bf16_t*)(F.ws + WS_SZ); bf16_t* OA = (bf16_t*)(F.ws + WS_OA);
    LAS unsigned char* Kl = F.lds; LAS unsigned char* Vl = F.lds + KV_IMG;
    const int lane = F.lane, w = F.wave, fr = lane & 15, fq = lane >> 4;
    constexpr int NUNITS = BATCH * NKVH * (SEQ / 128);
    const float NEG = -INFINITY;
    for (int un = F.vcu; un < NUNITS; un += F.G) {
        const int n = un & 31, hk = (un >> 5) & 3, b = un >> 7;
        const long band0 = (long)b * SEQ + 128 * (n - 1);
#pragma unroll
        for (int i = 0; i < 4; ++i) {
            const int idx = F.tid + 512 * i, r = idx >> 3, ch = idx & 7;
            u32x4 kv = (u32x4){0u, 0u, 0u, 0u}, vv = (u32x4){0u, 0u, 0u, 0u};
            if (n > 0 || r >= 128) { const size_t go = (size_t)(band0 + r) * KVW + hk * HD + ch * 8; kv = *(const u32x4*)(Kg + go); vv = *(const u32x4*)(Vg + go); }
            *(LAS u32x4*)(Kl + r * KV_STRIDE + ch * 16) = kv; *(LAS u32x4*)(Vl + r * KV_STRIDE + ch * 16) = vv;
        }
        const long qrow = (long)b * SEQ + 128 * n + 16 * w + fr;
        bf16x8 qf[4][2];
#pragma unroll
        for (int g = 0; g < 4; ++g)
#pragma unroll
            for (int s = 0; s < 2; ++s) qf[g][s] = *(const bf16x8*)(Qg + (size_t)qrow * DM + (hk * 4 + g) * HD + 32 * s + 8 * fq);
        __syncthreads();
        const LAS unsigned char* kbase = Kl + (16 * w + fr) * KV_STRIDE + 16 * fq;
        const LAS unsigned char* vbase = Vl + (16 * w + 4 * fq + (fr >> 2)) * KV_STRIDE + 8 * (fr & 3);
        const int t9 = (w + 9 > 15 ? 15 : w + 9) - w;
#pragma unroll 1
        for (int g = 0; g < 4; ++g) {
            const int h = hk * 4 + g;
            const float sink2 = F.sinks[l * NQH + h] * LOG2E;
            u32x2 szv[4];
#pragma unroll
            for (int dt = 0; dt < 4; ++dt) szv[dt] = *(const u32x2*)(SZ + (size_t)qrow * DM + h * HD + 16 * dt + 4 * fq);
            f32x4 st[9];
#pragma unroll
            for (int j = 0; j < 9; ++j) {
                const bf16x8 k0 = *(const LAS bf16x8*)(kbase + j * 16 * KV_STRIDE), k1 = *(const LAS bf16x8*)(kbase + j * 16 * KV_STRIDE + 64);
                f32x4 a = __builtin_amdgcn_mfma_f32_16x16x32_bf16(k0, qf[g][0], (f32x4){0.f, 0.f, 0.f, 0.f}, 0, 0, 0);
                st[j] = __builtin_amdgcn_mfma_f32_16x16x32_bf16(k1, qf[g][1], a, 0, 0, 0);
            }
#pragma unroll
            for (int i = 0; i < 4; ++i) { const int kk = 4 * fq + i; if (!(kk > fr)) st[0][i] = NEG; if (kk > fr) st[8][i] = NEG; }
            if (n == 0) {
#pragma unroll
                for (int j = 0; j < 8; ++j) if (w + j < 8) st[j] = (f32x4){NEG, NEG, NEG, NEG};
            }
            float mx = sink2;
#pragma unroll
            for (int j = 0; j < 9; ++j) mx = fmaxf(mx, fmaxf(fmaxf(st[j][0], st[j][1]), fmaxf(st[j][2], st[j][3])));
            mx = fmaxf(mx, __shfl_xor(mx, 16)); mx = fmaxf(mx, __shfl_xor(mx, 32));
            float sum = 0.f;
#pragma unroll
            for (int j = 0; j < 9; ++j)
#pragma unroll
                for (int i = 0; i < 4; ++i) { st[j][i] = __builtin_amdgcn_exp2f(st[j][i] - mx); sum += st[j][i]; }
            sum += __shfl_xor(sum, 16); sum += __shfl_xor(sum, 32);
            const float inv = 1.0f / (sum + __builtin_amdgcn_exp2f(sink2 - mx));
            f32x4 ot[4];
#pragma unroll
            for (int dt = 0; dt < 4; ++dt) ot[dt] = (f32x4){0.f, 0.f, 0.f, 0.f};
#pragma unroll
            for (int s = 0; s < 5; ++s) {
                u32x4 pw;
                pw.x = cvt_pk_bf16(st[2 * s][0], st[2 * s][1]); pw.y = cvt_pk_bf16(st[2 * s][2], st[2 * s][3]);
                if (s < 4) { pw.z = cvt_pk_bf16(st[2 * s + 1][0], st[2 * s + 1][1]); pw.w = cvt_pk_bf16(st[2 * s + 1][2], st[2 * s + 1][3]); } else { pw.z = 0u; pw.w = 0u; }
                const bf16x8 pf = __builtin_bit_cast(bf16x8, pw);
                const int off0 = (2 * s) * 16 * KV_STRIDE, off1 = (s < 4 ? (2 * s + 1) : t9) * 16 * KV_STRIDE;
#pragma unroll
                for (int dt = 0; dt < 4; ++dt) {
                    const s16x4 lo = __builtin_bit_cast(s16x4, __builtin_amdgcn_ds_read_tr16_b64_v4i16((LAS s16x4*)(vbase + off0 + 32 * dt)));
                    const s16x4 hi = __builtin_bit_cast(s16x4, __builtin_amdgcn_ds_read_tr16_b64_v4i16((LAS s16x4*)(vbase + off1 + 32 * dt)));
                    const bf16x8 vf = (bf16x8){lo[0], lo[1], lo[2], lo[3], hi[0], hi[1], hi[2], hi[3]};
                    ot[dt] = __builtin_amdgcn_mfma_f32_16x16x32_bf16(vf, pf, ot[dt], 0, 0, 0);
                }
            }
#pragma unroll
            for (int dt = 0; dt < 4; ++dt) {
                u32x2 o; o.x = cvt_pk_bf16(ot[dt][0] * inv * bf_lo(szv[dt].x), ot[dt][1] * inv * bf_hi(szv[dt].x)); o.y = cvt_pk_bf16(ot[dt][2] * inv * bf_lo(szv[dt].y), ot[dt][3] * inv * bf_hi(szv[dt].y));
                *(u32x2*)(OA + (size_t)qrow * DM + h * HD + 16 * dt + 4 * fq) = o;
            }
        }
        __syncthreads();
    }
}

struct Args { const float* in[11]; float* out; unsigned char* ws; int ph_lo, ph_hi; };
constexpr int NPHASES = 1 + 4 * DEPTH;

__global__ void __launch_bounds__(NWAVES * 64, 2) fwd_kernel(Args args) {
    extern __shared__ __attribute__((aligned(16))) unsigned char lds_raw[];
    const int lo = args.ph_lo, hi = args.ph_hi;
    for (int ph = lo; ph < hi; ++ph) {
        if (ph > lo) { cg::this_grid().sync(); }
        Frame F;
        F.lds = (LAS unsigned char*)lds_raw;
        { int t = threadIdx.x; asm volatile("" : "+v"(t)); F.tid = t; }
        F.lane = F.tid & 63; F.wave = __builtin_amdgcn_readfirstlane(F.tid >> 6);
        { int gsz = gridDim.x, bx = blockIdx.x; asm volatile("" : "+s"(gsz), "+s"(bx)); F.G = gsz; F.bx = bx; F.vcu = (F.G % 8 == 0) ? (bx % 8) * (F.G / 8) + bx / 8 : bx; }
        F.x = args.in[0]; F.norm_g = args.in[1]; F.w_in = args.in[2]; F.conv_w = args.in[3]; F.qng = args.in[4]; F.kng = args.in[5]; F.sinks = args.in[6];
        F.w_co = args.in[7]; F.w_ao = args.in[8]; F.gate_b = args.in[9]; F.w_out = args.in[10]; F.out = args.out;
        unsigned char* ws = args.ws; asm volatile("" : "+s"(ws)); F.ws = ws;
        float* rowss = (float*)(ws + WS_ROWSS);
        bf16_t* XB = (bf16_t*)(ws + WS_XB);
        if (ph == 0) { p0_prologue(F); continue; }
        const int l = (ph - 1) >> 2, s = (ph - 1) & 3;
        unsigned char* wl = ws + WS_W + (size_t)l * W_LAYER;
        if (s == 0) {
            pg8::Gemm g{XB, (const bf16_t*)wl, XB, (const bf16_t*)wl, DM};
            pg8::StaticOrder S; S.init(M, NCOLS, F.G, F.bx, 1);
            EpiIn E{(bf16_t*)(ws + WS_CV), (bf16_t*)(ws + WS_Q), (bf16_t*)(ws + WS_K), (bf16_t*)(ws + WS_V), (bf16_t*)(ws + WS_SZ), (bf16_t*)(ws + WS_G),
                    rowss + (size_t)l * M, F.qng + l * HD, F.kng + l * HD, F.gate_b + l * 2 * DM};
            pg8::gemm_phase<EpiIn, true, true>(F.lds, F.tid, g, S, E);
        } else if (s == 1) {
            attn_phase(F, l);
            conv_phase(F, l);
        } else if (s == 2) {
            pg8::Gemm g{(const bf16_t*)(ws + WS_YC), (const bf16_t*)(wl + W_CO), (const bf16_t*)(ws + WS_OA), (const bf16_t*)(wl + W_AO), DM};
            pg8::StaticOrder S; S.init(M, DM, F.G, F.bx, 2);
            EpiMerge E{(const bf16_t*)(ws + WS_G), (bf16_t*)(ws + WS_MG)};
            pg8::gemm_phase<EpiMerge, true, true>(F.lds, F.tid, g, S, E);
        } else {
            pg8::Gemm g{(const bf16_t*)(ws + WS_MG), (const bf16_t*)(wl + W_OUT), (const bf16_t*)(ws + WS_MG), (const bf16_t*)(wl + W_OUT), DM};
            pg8::StaticOrder S; S.init(M, DM, F.G, F.bx, 1);
            const bool lastl = (l == DEPTH - 1);
            EpiOut E{l == 0 ? F.x : F.out, F.out, XB, lastl ? nullptr : rowss + (size_t)(l + 1) * M};
            pg8::gemm_phase<EpiOut, true, true>(F.lds, F.tid, g, S, E);
        }
    }
}

extern "C" void kernel_launch(void* const* d_in, const int* in_sizes, int n_in, void* d_out, int out_size, void* d_ws, size_t ws_size, hipStream_t stream) {
    static int grid = 0;
    if (grid == 0) {
        if (n_in != 11 || in_sizes[0] != M * DM || out_size != M * DM || ws_size < WS_END) {
            fprintf(stderr, "kernel_launch: unexpected shapes: n_in %d in0 %d out %d ws %zu (need %zu)\n", n_in, n_in > 0 ? in_sizes[0] : -1, out_size, ws_size, (size_t)WS_END); grid = -1; return; }
        int dev = 0, cus = 0, per_cu = 0;
        hipGetDevice(&dev); hipDeviceGetAttribute(&cus, hipDeviceAttributeMultiprocessorCount, dev);
        if (hipFuncSetAttribute((const void*)fwd_kernel, hipFuncAttributeMaxDynamicSharedMemorySize, LDS_BYTES) != hipSuccess) { fprintf(stderr, "kernel_launch: hipFuncSetAttribute failed\n"); grid = -1; return; }
        if (hipOccupancyMaxActiveBlocksPerMultiprocessor(&per_cu, (const void*)fwd_kernel, NWAVES * 64, LDS_BYTES) != hipSuccess || per_cu < 1) { fprintf(stderr, "kernel_launch: occupancy query says %d\n", per_cu); per_cu = 1; }
        (void)hipGetLastError();
        grid = cus * 1;
        fprintf(stderr, "kernel_launch: grid %d (cus %d, per_cu %d)\n", grid, cus, per_cu);
    }
    if (grid < 0) return;
    Args a{};
    for (int i = 0; i < 11; ++i) a.in[i] = (const float*)d_in[i];
    a.out = (float*)d_out; a.ws = (unsigned char*)d_ws;
#if MK_ONE_LAUNCH
    a.ph_lo = 0; a.ph_hi = NPHASES;
    void* kargs[] = {&a};
    hipError_t e = hipLaunchCooperativeKernel((const void*)fwd_kernel, dim3(grid), dim3(NWAVES * 64), kargs, LDS_BYTES, stream);
    if (e != hipSuccess) fprintf(stderr, "kernel_launch: cooperative launch failed: %s (grid %d)\n", hipGetErrorString(e), grid);
#else
    for (int p = 0; p < NPHASES; ++p) { a.ph_lo = p; a.ph_hi = p + 1; hipLaunchKernelGGL(fwd_kernel, dim3(grid), dim3(NWAVES * 64), LDS_BYTES, stream, a); }
#endif
}
```

```cpp
#include <hip/hip_runtime.h>
#include <hip/hip_cooperative_groups.h>
#include <cstdio>
#include <cstdint>
namespace cg = cooperative_groups;

#ifndef PROBE_DUP
#define PROBE_DUP 0
#endif
#ifndef MK_ONE_LAUNCH
#define MK_ONE_LAUNCH 1
#endif

#define LAS __attribute__((address_space(3)))
typedef unsigned short bf16_t;
typedef short bf16x8 __attribute__((ext_vector_type(8)));
typedef short s16x4 __attribute__((ext_vector_type(4)));
typedef float f32x4 __attribute__((ext_vector_type(4)));
typedef unsigned u32x4 __attribute__((ext_vector_type(4)));
typedef unsigned u32x2 __attribute__((ext_vector_type(2)));

constexpr int DM = 1024, BATCH = 4, SEQ = 4096, DEPTH = 4, M = BATCH * SEQ;
constexpr int NQH = 16, NKVH = 4, HD = 64, KVW = NKVH * HD;
constexpr int NCOLS = 4 * DM + DM + 2 * KVW + DM + 2 * DM;
constexpr float EPS = 1e-6f;
constexpr float LOG2E = 1.4426950408889634f;
constexpr float QSCALE = 0.125f * LOG2E;

constexpr size_t MiB = 1u << 20;
constexpr size_t WS_ROWSS = 0;
constexpr size_t WS_CTL = 512 * 1024, CTL_BYTES = 16384;
constexpr size_t WS_W = 1 * MiB;
constexpr size_t W_LAYER = 23 * MiB, W_CO = 17 * MiB, W_AO = 19 * MiB, W_OUT = 21 * MiB;
constexpr size_t WS_XB = 96 * MiB;
constexpr size_t WS_CV = 128 * MiB;
constexpr size_t WS_Q = 256 * MiB;
constexpr size_t WS_K = 288 * MiB;
constexpr size_t WS_V = 296 * MiB;
constexpr size_t WS_SZ = 304 * MiB;
constexpr size_t WS_G = 336 * MiB;
constexpr size_t WS_YC = 400 * MiB;
constexpr size_t WS_OA = 432 * MiB;
constexpr size_t WS_MG = 464 * MiB;
constexpr size_t WS_END = 496 * MiB;

constexpr int NWAVES = 8;
constexpr int LDS_BYTES = 147456;

typedef float f32x2_t __attribute__((ext_vector_type(2))); typedef __bf16 bf16x2_t __attribute__((ext_vector_type(2)));
__device__ __forceinline__ unsigned cvt_pk_bf16(float lo, float hi) { f32x2_t v = {lo, hi}; bf16x2_t b = __builtin_convertvector(v, bf16x2_t); return __builtin_bit_cast(unsigned, b); }
__device__ __forceinline__ float bf_lo(unsigned u) { return __uint_as_float(u << 16); }
__device__ __forceinline__ float bf_hi(unsigned u) { return __uint_as_float(u & 0xffff0000u); }
__device__ __forceinline__ float fast_sigmoid(float v) { return __builtin_amdgcn_rcpf(1.0f + __builtin_amdgcn_exp2f(-v * LOG2E)); }

namespace pg8 {
constexpr int BM = 256, BK = 64, HALF = 128, HTB = HALF * BK * 2, STAGE_BYTES = 8 * HTB, NXCD = 8, WGM = 8;
__host__ __device__ __forceinline__ int lds_byte(int r, int c) { const int st = (r >> 4) * 2 + (c >> 5), rr = r & 15, cc = c & 31, ob = rr * 64 + cc * 2; return st * 1024 + (ob ^ (((ob >> 9) & 1) << 5)); }
__host__ __device__ __forceinline__ void stage_rc(int b, int& R, int& C) { const int st = b / 1024, sb = b % 1024, swz = sb ^ (((sb >> 9) & 1) << 5); R = (st >> 1) * 16 + swz / 64; C = (st & 1) * 32 + (swz % 64) / 2; }
__host__ __device__ __forceinline__ int perm32(int rho) { const int n = rho >> 4, i = rho & 15; return 8 * (i >> 2) + 4 * n + (i & 3); }

struct Unit { int pm, pn, seg; };
struct Gemm { const bf16_t* A0; const bf16_t* B0; const bf16_t* A1; const bf16_t* B1; int K; };

struct StaticOrder {
    int nM, nN, nwg, G, c, nseg;
    __device__ void init(int M_, int N_, int G_, int c_, int nseg_) { nM = M_ / BM; nN = N_ / BM; nwg = nM * nN; G = G_; c = c_; nseg = nseg_; }
    __device__ bool next(int i, Unit& u) const {
        int ti = i; u.seg = 0;
        if (nseg == 2) { ti = i >> 1; u.seg = i & 1; }
        const long L = (long)ti * G + c; if (L >= nwg) return false;
        int wgid = (int)L; { const int q = nwg / NXCD, r = nwg % NXCD, xcd = wgid % NXCD, off = wgid / NXCD; wgid = (xcd < r ? xcd * (q + 1) : r * (q + 1) + (xcd - r) * q) + off; }
        const int nig = WGM * nN, gid = wgid / nig, fm = gid * WGM, gsz = (nM - fm) < WGM ? (nM - fm) : WGM;
        u.pm = fm + ((wgid % nig) % gsz); u.pn = (wgid % nig) / gsz; return true;
    }
};

typedef f32x4 Acc[2][2][4][2];

template <class Epi, bool ALIGN_EPI, bool SP2>
__device__ __forceinline__ void gemm_phase(LAS unsigned char* lds, const int tid, const Gemm g, const StaticOrder& S, const Epi& E) {
    const int wid = __builtin_amdgcn_readfirstlane(tid >> 6), lane = tid & 63, wr = wid >> 2, wc = wid & 3, fr = lane & 15, fq = lane >> 4;
    const int K = g.K, nt = K / BK;
    unsigned voffA[2], voffB[2];
#pragma unroll
    for (int i = 0; i < 2; ++i) { int R, C; stage_rc(tid * 16 + i * 8192, R, C); const int Rb = Epi::PERM ? ((R & ~31) + perm32(R & 31)) : R;
        voffA[i] = (unsigned)(R * K + C) * 2u; voffB[i] = (unsigned)(Rb * K + C) * 2u; }
    const size_t kstep = (size_t)(BK * 2);
    const size_t hstep = (size_t)HALF * K * 2;
    const size_t tstep = 2 * hstep;
    const unsigned ldsw = (unsigned)wid * 1024u;
    const int aoff = lds_byte(wr * 64 + fr, fq * 8), boff = lds_byte(wc * 32 + fr, fq * 8);
#define PG8_SA(b, h) (((b) * 2 + (h)) * HTB)
#define PG8_SB(b, h) ((4 + (b) * 2 + (h)) * HTB)
#define PG8_STAGE(bufoff, gbase, voff) do { _Pragma("unroll") for (int _i = 0; _i < 2; ++_i) \
        __builtin_amdgcn_global_load_lds((const unsigned*)((const char*)(gbase) + (voff)[_i]), (LAS unsigned*)(lds + (bufoff) + ldsw + _i * 8192), 16, 0, 0); } while (0)
#define PG8_LDA(dst, b, h) do { _Pragma("unroll") for (int m = 0; m < 4; ++m) _Pragma("unroll") for (int k = 0; k < 2; ++k) dst[m][k] = *(const LAS bf16x8*)(lds + PG8_SA(b, h) + aoff + m * 2048 + k * 1024); } while (0)
#define PG8_LDB(dst, b, h) do { _Pragma("unroll") for (int n = 0; n < 2; ++n) _Pragma("unroll") for (int k = 0; k < 2; ++k) dst[n][k] = *(const LAS bf16x8*)(lds + PG8_SB(b, h) + boff + n * 2048 + k * 1024); } while (0)
#define PG8_MMA(ai, bj, At, Bt) do { __builtin_amdgcn_s_setprio(1); _Pragma("unroll") for (int m = 0; m < 4; ++m) _Pragma("unroll") for (int n = 0; n < 2; ++n) _Pragma("unroll") for (int k = 0; k < 2; ++k) \
        acc[ai][bj][m][n] = __builtin_amdgcn_mfma_f32_16x16x32_bf16(Bt[n][k], At[m][k], acc[ai][bj][m][n], 0, 0, 0); __builtin_amdgcn_s_setprio(0); } while (0)
#define PG8_WAIT_V(n) asm volatile("s_waitcnt vmcnt(" #n ")" ::: "memory")
#define PG8_WAIT_L(n) asm volatile("s_waitcnt lgkmcnt(" #n ")" ::: "memory")
#define PG8_BAR __builtin_amdgcn_s_barrier()
#define PG8_SCHED __builtin_amdgcn_sched_barrier(0)
    Unit cur, nxt; int ui = 0;
    if (!S.next(0, cur)) return;
    Acc acc;
#pragma unroll
    for (int a = 0; a < 2; ++a)
#pragma unroll
        for (int b = 0; b < 2; ++b)
#pragma unroll
            for (int m = 0; m < 4; ++m)
#pragma unroll
                for (int n = 0; n < 2; ++n) acc[a][b][m][n] = (f32x4){0.f, 0.f, 0.f, 0.f};
    bf16x8 At[4][2], B0[2][2], B1[2][2];
    const char* cA = (const char*)(cur.seg ? g.A1 : g.A0) + (size_t)cur.pm * tstep; const char* cB = (const char*)(cur.seg ? g.B1 : g.B0) + (size_t)cur.pn * tstep;
    if constexpr (SP2) {
        PG8_STAGE(PG8_SB(0, 0), cB, voffB); PG8_STAGE(PG8_SB(0, 1), cB + hstep, voffB); PG8_STAGE(PG8_SA(0, 0), cA, voffA); PG8_STAGE(PG8_SA(0, 1), cA + hstep, voffA);
        if (wr == 1) PG8_BAR;
        PG8_WAIT_V(2); PG8_BAR;
        PG8_STAGE(PG8_SB(1, 0), cB + kstep, voffB); PG8_STAGE(PG8_SA(1, 0), cA + kstep, voffA); PG8_STAGE(PG8_SB(1, 1), cB + hstep + kstep, voffB);
        PG8_WAIT_V(6); PG8_BAR;
    } else {
        PG8_STAGE(PG8_SB(0, 0), cB, voffB); PG8_STAGE(PG8_SA(0, 0), cA, voffA); PG8_STAGE(PG8_SB(0, 1), cB + hstep, voffB); PG8_STAGE(PG8_SA(0, 1), cA + hstep, voffA);
        if (wr == 1) PG8_BAR;
        PG8_WAIT_V(4); PG8_BAR;
        PG8_STAGE(PG8_SB(1, 0), cB + kstep, voffB); PG8_STAGE(PG8_SA(1, 0), cA + kstep, voffA); PG8_STAGE(PG8_SB(1, 1), cB + hstep + kstep, voffB);
        PG8_WAIT_V(6); PG8_BAR;
    }
    for (;;) {
        const bool has_next = S.next(ui + 1, nxt);
        const char* nA = has_next ? (const char*)(nxt.seg ? g.A1 : g.A0) + (size_t)nxt.pm * tstep : cA; const char* nB = has_next ? (const char*)(nxt.seg ? g.B1 : g.B0) + (size_t)nxt.pn * tstep : cB;
        for (int t = 0; t < nt; t += 2) {
            const bool last = (t == nt - 2);
            const char* a1 = cA + (size_t)(t + 1) * kstep;
            const char* a2 = last ? nA : cA + (size_t)(t + 2) * kstep; const char* b2 = last ? nB : cB + (size_t)(t + 2) * kstep;
            const char* a3 = a2 + kstep; const char* b3 = b2 + kstep;
            if constexpr (SP2) {
            PG8_LDB(B0, 0, 0); PG8_LDB(B1, 0, 1); PG8_SCHED; PG8_LDA(At, 0, 0); PG8_STAGE(PG8_SA(1, 1), a1 + hstep, voffA);
            PG8_WAIT_V(8); PG8_WAIT_L(0); PG8_BAR; PG8_MMA(0, 0, At, B0); PG8_MMA(0, 1, At, B1); PG8_BAR; PG8_SCHED;
            PG8_LDA(At, 0, 1); PG8_STAGE(PG8_SB(0, 0), b2, voffB); PG8_STAGE(PG8_SB(0, 1), b2 + hstep, voffB); PG8_STAGE(PG8_SA(0, 0), a2, voffA);
            PG8_WAIT_V(8); PG8_WAIT_L(0); PG8_BAR; PG8_MMA(1, 0, At, B0); PG8_MMA(1, 1, At, B1); PG8_BAR; PG8_SCHED;
            PG8_LDB(B0, 1, 0); PG8_LDB(B1, 1, 1); PG8_SCHED; PG8_LDA(At, 1, 0); PG8_STAGE(PG8_SA(0, 1), a2 + hstep, voffA);
            PG8_WAIT_V(8); PG8_WAIT_L(0); PG8_BAR; PG8_MMA(0, 0, At, B0); PG8_MMA(0, 1, At, B1); PG8_BAR; PG8_SCHED;
            PG8_LDA(At, 1, 1); PG8_STAGE(PG8_SB(1, 0), b3, voffB); PG8_STAGE(PG8_SB(1, 1), b3 + hstep, voffB); PG8_STAGE(PG8_SA(1, 0), a3, voffA);
            PG8_WAIT_V(8); PG8_WAIT_L(0); PG8_BAR; PG8_MMA(1, 0, At, B0); PG8_MMA(1, 1, At, B1); PG8_BAR; PG8_SCHED;
            } else {
            PG8_LDB(B0, 0, 0); PG8_SCHED; PG8_LDA(At, 0, 0); PG8_STAGE(PG8_SA(1, 1), a1 + hstep, voffA);
            PG8_WAIT_L(8); PG8_BAR; PG8_WAIT_L(0); PG8_MMA(0, 0, At, B0); PG8_BAR; PG8_SCHED;
            PG8_LDB(B1, 0, 1); PG8_STAGE(PG8_SB(0, 0), b2, voffB);
            PG8_BAR; PG8_WAIT_L(0); PG8_MMA(0, 1, At, B1); PG8_BAR;
            PG8_LDA(At, 0, 1); PG8_STAGE(PG8_SA(0, 0), a2, voffA);
            PG8_BAR; PG8_WAIT_L(0); PG8_MMA(1, 0, At, B0); PG8_BAR; PG8_SCHED;
            PG8_STAGE(PG8_SB(0, 1), b2 + hstep, voffB);
            PG8_WAIT_V(6); PG8_BAR; PG8_MMA(1, 1, At, B1); PG8_BAR;
            PG8_LDB(B0, 1, 0); PG8_SCHED; PG8_LDA(At, 1, 0); PG8_STAGE(PG8_SA(0, 1), a2 + hstep, voffA);
            PG8_WAIT_L(8); PG8_BAR; PG8_WAIT_L(0); PG8_MMA(0, 0, At, B0); PG8_BAR; PG8_SCHED;
            PG8_LDB(B1, 1, 1); PG8_STAGE(PG8_SB(1, 0), b3, voffB);
            PG8_BAR; PG8_WAIT_L(0); PG8_MMA(0, 1, At, B1); PG8_BAR;
            PG8_LDA(At, 1, 1); PG8_STAGE(PG8_SA(1, 0), a3, voffA);
            PG8_BAR; PG8_WAIT_L(0); PG8_MMA(1, 0, At, B0); PG8_BAR; PG8_SCHED;
            PG8_STAGE(PG8_SB(1, 1), b3 + hstep, voffB);
            PG8_WAIT_V(6); PG8_BAR; PG8_MMA(1, 1, At, B1); PG8_BAR;
            }
        }
        if constexpr (ALIGN_EPI) { if (wr == 0) PG8_BAR; }
        bool keep = false;
        if constexpr (Epi::TWO_SEG) { if (cur.seg == 0) { E.mid(acc, cur, wr, wc, fr, fq); keep = true; } else E(acc, cur, wr, wc, fr, fq); }
        else E(acc, cur, wr, wc, fr, fq);
        if (!has_next) break;
        if (!keep) {
#pragma unroll
        for (int a = 0; a < 2; ++a)
#pragma unroll
            for (int b = 0; b < 2; ++b)
#pragma unroll
                for (int m = 0; m < 4; ++m)
#pragma unroll
                    for (int n = 0; n < 2; ++n) acc[a][b][m][n] = (f32x4){0.f, 0.f, 0.f, 0.f};
        }
        cur = nxt; cA = nA; cB = nB; ++ui;
        if constexpr (ALIGN_EPI) { if (wr == 1) PG8_BAR; }
    }
    PG8_WAIT_V(0);
    if constexpr (!ALIGN_EPI) { if (wr == 0) PG8_BAR; }
    PG8_BAR;
#undef PG8_SA
#undef PG8_SB
#undef PG8_STAGE
#undef PG8_LDA
#undef PG8_LDB
#undef PG8_MMA
#undef PG8_WAIT_V
#undef PG8_WAIT_L
#undef PG8_BAR
#undef PG8_SCHED
}
}

struct EpiIn {
    static constexpr bool PERM = true, TWO_SEG = false;
    bf16_t *CV, *Q, *Kb, *Vb, *SZ, *G; const float *rowss, *qg, *kg, *gate_b;
    __device__ __forceinline__ void store8(bf16_t* p, const f32x4& v0, const f32x4& v1) const {
        u32x4 w; w.x = cvt_pk_bf16(v0[0], v0[1]); w.y = cvt_pk_bf16(v0[2], v0[3]); w.z = cvt_pk_bf16(v1[0], v1[1]); w.w = cvt_pk_bf16(v1[2], v1[3]); *(u32x4*)p = w; }
    __device__ __forceinline__ void operator()(pg8::Acc& acc, const pg8::Unit& u, int wr, int wc, int fr, int fq) const {
        const int row0 = u.pm * 256 + wr * 64 + fr; const int pn = u.pn;
        float rs[2][4];
#pragma unroll
        for (int ai = 0; ai < 2; ++ai)
#pragma unroll
            for (int m = 0; m < 4; ++m) rs[ai][m] = 1.0f / sqrtf(rowss[row0 + ai * 128 + m * 16] * (1.0f / DM) + EPS);
        if (pn < 16 || pn == 21 || (pn >= 22 && pn < 26)) {
            bf16_t* base; int ld, colt; const bool act = (pn >= 22);
            if (pn < 16) { base = CV + (size_t)(pn >> 2) * ((size_t)M * DM); ld = DM; colt = (pn & 3) * 256; }
            else if (pn == 21) { base = Vb; ld = KVW; colt = 0; }
            else { base = SZ; ld = DM; colt = (pn - 22) * 256; }
            const int col0 = colt + wc * 32 + 8 * fq;
#pragma unroll
            for (int ai = 0; ai < 2; ++ai)
#pragma unroll
                for (int m = 0; m < 4; ++m) { bf16_t* rowp = base + (size_t)(row0 + ai * 128 + m * 16) * ld + col0; const float r = rs[ai][m];
#pragma unroll
                    for (int bj = 0; bj < 2; ++bj) { f32x4 v0 = acc[ai][bj][m][0] * r, v1 = acc[ai][bj][m][1] * r;
                        if (act) {
#pragma unroll
                            for (int i = 0; i < 4; ++i) { v0[i] = v0[i] * fast_sigmoid(v0[i]); v1[i] = v1[i] * fast_sigmoid(v1[i]); } }
                        store8(rowp + bj * 128, v0, v1); } }
        } else if (pn >= 26) {
            const int colt = (pn - 26) * 256, col0 = colt + wc * 32 + 8 * fq;
            f32x4 bv[2][2];
#pragma unroll
            for (int bj = 0; bj < 2; ++bj)
#pragma unroll
                for (int n = 0; n < 2; ++n) bv[bj][n] = *(const f32x4*)(gate_b + col0 + bj * 128 + 4 * n);
#pragma unroll
            for (int ai = 0; ai < 2; ++ai)
#pragma unroll
                for (int m = 0; m < 4; ++m) { bf16_t* rowp = G + (size_t)(row0 + ai * 128 + m * 16) * (2 * DM) + col0; const float r = rs[ai][m];
#pragma unroll
                    for (int bj = 0; bj < 2; ++bj) { f32x4 v0 = acc[ai][bj][m][0] * r + bv[bj][0], v1 = acc[ai][bj][m][1] * r + bv[bj][1];
#pragma unroll
                        for (int i = 0; i < 4; ++i) { v0[i] = fast_sigmoid(v0[i]); v1[i] = fast_sigmoid(v1[i]); }
                        store8(rowp + bj * 128, v0, v1); } }
        } else {
            const bool isq = pn < 20; bf16_t* base = isq ? Q : Kb; const int ld = isq ? DM : KVW, colt = isq ? (pn - 16) * 256 : 0;
            const float* gp = isq ? qg : kg; const float sc = isq ? QSCALE : 1.0f;
            f32x4 gv[2][2];
#pragma unroll
            for (int bj = 0; bj < 2; ++bj)
#pragma unroll
                for (int n = 0; n < 2; ++n) gv[bj][n] = *(const f32x4*)(gp + 32 * bj + 8 * fq + 4 * n) * sc;
            const int col0 = colt + wc * 64 + 8 * fq;
#pragma unroll
            for (int ai = 0; ai < 2; ++ai)
#pragma unroll
                for (int m = 0; m < 4; ++m) { bf16_t* rowp = base + (size_t)(row0 + ai * 128 + m * 16) * ld + col0; const float r = rs[ai][m];
                    f32x4 v[2][2]; float ss = 0.f;
#pragma unroll
                    for (int bj = 0; bj < 2; ++bj)
#pragma unroll
                        for (int n = 0; n < 2; ++n) { v[bj][n] = acc[ai][bj][m][n] * r; ss += (v[bj][n][0] * v[bj][n][0] + v[bj][n][1] * v[bj][n][1]) + (v[bj][n][2] * v[bj][n][2] + v[bj][n][3] * v[bj][n][3]); }
                    ss += __shfl_xor(ss, 16); ss += __shfl_xor(ss, 32);
                    const float rq = 1.0f / sqrtf(ss * (1.0f / HD) + EPS);
#pragma unroll
                    for (int bj = 0; bj < 2; ++bj) store8(rowp + bj * 32, v[bj][0] * rq * gv[bj][0], v[bj][1] * rq * gv[bj][1]); }
        }
    }
};

struct EpiMerge {
    static constexpr bool PERM = true, TWO_SEG = true;
    const bf16_t* G; bf16_t* MG;
    __device__ __forceinline__ void mid(pg8::Acc& acc, const pg8::Unit& u, int wr, int wc, int fr, int fq) const {
        const int row0 = u.pm * 256 + wr * 64 + fr, col0 = u.pn * 256 + wc * 32 + 8 * fq;
#pragma unroll
        for (int ai = 0; ai < 2; ++ai)
#pragma unroll
            for (int m = 0; m < 4; ++m) { const bf16_t* gp = G + (size_t)(row0 + ai * 128 + m * 16) * (2 * DM) + col0;
#pragma unroll
                for (int bj = 0; bj < 2; ++bj) { const u32x4 a = *(const u32x4*)(gp + bj * 128), b = *(const u32x4*)(gp + DM + bj * 128);
#pragma unroll
                    for (int j = 0; j < 4; ++j) { const float r0 = bf_lo(a[j]) * __builtin_amdgcn_rcpf(fmaxf(bf_lo(b[j]), 1e-30f)), r1 = bf_hi(a[j]) * __builtin_amdgcn_rcpf(fmaxf(bf_hi(b[j]), 1e-30f));
                        acc[ai][bj][m][j >> 1][(j & 1) * 2] *= r0; acc[ai][bj][m][j >> 1][(j & 1) * 2 + 1] *= r1; } } }
    }
    __device__ __forceinline__ void operator()(pg8::Acc& acc, const pg8::Unit& u, int wr, int wc, int fr, int fq) const {
        const int row0 = u.pm * 256 + wr * 64 + fr, col0 = u.pn * 256 + wc * 32 + 8 * fq;
#pragma unroll
        for (int ai = 0; ai < 2; ++ai)
#pragma unroll
            for (int m = 0; m < 4; ++m) { const size_t ro = (size_t)(row0 + ai * 128 + m * 16); const bf16_t* gp = G + ro * (2 * DM) + DM + col0; bf16_t* op = MG + ro * DM + col0;
#pragma unroll
                for (int bj = 0; bj < 2; ++bj) { const u32x4 b = *(const u32x4*)(gp + bj * 128); u32x4 w;
#pragma unroll
                    for (int j = 0; j < 4; ++j) w[j] = cvt_pk_bf16(acc[ai][bj][m][j >> 1][(j & 1) * 2] * bf_lo(b[j]), acc[ai][bj][m][j >> 1][(j & 1) * 2 + 1] * bf_hi(b[j]));
                    *(u32x4*)(op + bj * 128) = w; } }
    }
};

struct EpiOut {
    static constexpr bool PERM = false, TWO_SEG = false;
    const float* xin; float* xout; bf16_t* XB; float* rowss_next;
    __device__ __forceinline__ void operator()(pg8::Acc& acc, const pg8::Unit& u, int wr, int wc, int fr, int fq) const {
        const int row0 = u.pm * 256 + wr * 64 + fr, col0 = u.pn * 256 + wc * 32 + 4 * fq;
#pragma unroll
        for (int ai = 0; ai < 2; ++ai)
#pragma unroll
            for (int m = 0; m < 4; ++m) { const size_t off = (size_t)(row0 + ai * 128 + m * 16) * DM + col0; float ss = 0.f;
#pragma unroll
                for (int bj = 0; bj < 2; ++bj)
#pragma unroll
                    for (int n = 0; n < 2; ++n) { const f32x4 xv = *(const f32x4*)(xin + off + bj * 128 + n * 16); const f32x4 o = xv + acc[ai][bj][m][n];
                        *(f32x4*)(xout + off + bj * 128 + n * 16) = o; ss += (o[0] * o[0] + o[1] * o[1]) + (o[2] * o[2] + o[3] * o[3]);
                        if (rowss_next) { u32x2 w; w.x = cvt_pk_bf16(o[0], o[1]); w.y = cvt_pk_bf16(o[2], o[3]); *(u32x2*)(XB + off + bj * 128 + n * 16) = w; } }
                if (rowss_next) { ss += __shfl_xor(ss, 16); ss += __shfl_xor(ss, 32); if (fq == 0) atomicAdd(rowss_next + row0 + ai * 128 + m * 16, ss); } }
    }
};

struct Frame {
    LAS unsigned char* lds; int tid, lane, wave, vcu, G, bx;
    const float *x, *norm_g, *w_in, *conv_w, *qng, *kng, *sinks, *w_co, *w_ao, *gate_b, *w_out; float* out; unsigned char* ws;
};
__device__ __forceinline__ float wave_sum(float v) {
#pragma unroll
    for (int o = 1; o < 64; o <<= 1) v += __shfl_xor(v, o);
    return v;
}
__device__ __forceinline__ void p0_transpose_item(const float* W, int K, int N, bf16_t* WT, const float* gk, int plo, int phi, LAS float* scr, int item, int lane) {
    const int nblk = N / 32, kb = item / nblk, nb = item % nblk, k0 = 64 * kb, n0 = 32 * nb;
#pragma unroll 8
    for (int i = 0; i < 32; ++i) { const int kk = 2 * i + (lane >> 5); float w = W[(size_t)(k0 + kk) * N + n0 + (lane & 31)]; if (gk) w *= gk[k0 + kk]; scr[kk * 33 + (lane & 31)] = w; }
    asm volatile("s_waitcnt lgkmcnt(0)" ::: "memory");
    int d0 = n0;
    if (n0 >= plo && n0 < phi) { const int t = n0 & 255, wc_ = t >> 6, bj_ = (t >> 5) & 1; d0 = (n0 & ~255) + 128 * bj_ + 32 * wc_; }
    const int c = lane & 7;
#pragma unroll
    for (int j = 0; j < 4; ++j) { const int n = (lane >> 3) + 8 * j; const LAS float* s = scr + (8 * c) * 33 + n;
        u32x4 o; o.x = cvt_pk_bf16(s[0 * 33], s[1 * 33]); o.y = cvt_pk_bf16(s[2 * 33], s[3 * 33]); o.z = cvt_pk_bf16(s[4 * 33], s[5 * 33]); o.w = cvt_pk_bf16(s[6 * 33], s[7 * 33]);
        *(u32x4*)(WT + (size_t)(d0 + n) * K + k0 + 8 * c) = o; }
    asm volatile("s_waitcnt lgkmcnt(0)" ::: "memory");
}
__device__ __forceinline__ void p0_prologue(Frame& F) {
    LAS float* scr = (LAS float*)(F.lds + F.wave * 16384);
    const int gw = F.vcu * NWAVES + F.wave, NGW = F.G * NWAVES;
    constexpr int I_IN = (DM / 64) * (NCOLS / 32), I_SQ = (DM / 64) * (DM / 32), I_L = I_IN + 3 * I_SQ;
    for (int it = gw; it < DEPTH * I_L; it += NGW) {
        const int l = it / I_L; int r = it - l * I_L;
        unsigned char* wl = F.ws + WS_W + (size_t)l * W_LAYER;
        if (r < I_IN) { p0_transpose_item(F.w_in + (size_t)l * DM * NCOLS, DM, NCOLS, (bf16_t*)wl, F.norm_g + l * DM, 4 * DM, 4 * DM + DM + KVW, scr, r, F.lane); continue; } r -= I_IN;
        if (r < I_SQ) { p0_transpose_item(F.w_co + (size_t)l * DM * DM, DM, DM, (bf16_t*)(wl + W_CO), nullptr, 0, 0, scr, r, F.lane); continue; } r -= I_SQ;
        if (r < I_SQ) { p0_transpose_item(F.w_ao + (size_t)l * DM * DM, DM, DM, (bf16_t*)(wl + W_AO), nullptr, 0, 0, scr, r, F.lane); continue; } r -= I_SQ;
        p0_transpose_item(F.w_out + (size_t)l * DM * DM, DM, DM, (bf16_t*)(wl + W_OUT), nullptr, 0, 0, scr, r, F.lane);
    }
    float* rowss = (float*)(F.ws + WS_ROWSS); bf16_t* XB = (bf16_t*)(F.ws + WS_XB);
    for (int m = gw; m < M; m += NGW) {
        const f32x4* xr = (const f32x4*)(F.x + (size_t)m * DM) + F.lane; f32x4 v[4]; float s = 0.f;
#pragma unroll
        for (int j = 0; j < 4; ++j) { v[j] = xr[64 * j]; s += (v[j].x * v[j].x + v[j].y * v[j].y) + (v[j].z * v[j].z + v[j].w * v[j].w); }
        s = wave_sum(s);
        u32x2* o8 = (u32x2*)(XB + (size_t)m * DM) + F.lane;
#pragma unroll
        for (int j = 0; j < 4; ++j) { u32x2 w; w.x = cvt_pk_bf16(v[j].x, v[j].y); w.y = cvt_pk_bf16(v[j].z, v[j].w); o8[64 * j] = w; }
        if (F.lane == 0) rowss[m] = s;
        if (F.lane >= 1 && F.lane < DEPTH) rowss[(size_t)F.lane * M + m] = 0.f;
    }
}

__device__ __forceinline__ void conv_phase(Frame& F, int l) {
    const bf16_t* CVv = (const bf16_t*)(F.ws + WS_CV); const bf16_t* CVb = CVv + (size_t)M * DM; const bf16_t* CVc = CVb + (size_t)M * DM; const bf16_t* CVz = CVc + (size_t)M * DM;
    bf16_t* YC = (bf16_t*)(F.ws + WS_YC);
    const int cg8 = F.tid & 127, sub = F.tid >> 7;
    const float* cw = F.conv_w + (size_t)l * 3 * DM + cg8 * 8;
    float w0[8], w1[8], w2[8];
#pragma unroll
    for (int j = 0; j < 8; ++j) { w0[j] = cw[j]; w1[j] = cw[DM + j]; w2[j] = cw[2 * DM + j]; }
    for (int it = F.vcu; it < M / 64; it += F.G) {
        const int t0 = it * 64 + sub * 16; const size_t o0 = (size_t)t0 * DM + cg8 * 8;
        float p2[8], p1[8];
        if ((t0 & (SEQ - 1)) == 0) {
#pragma unroll
            for (int j = 0; j < 8; ++j) { p2[j] = 0.f; p1[j] = 0.f; }
        } else {
            const u32x4 va = *(const u32x4*)(CVv + o0 - 2 * DM), ca = *(const u32x4*)(CVc + o0 - 2 * DM), vb = *(const u32x4*)(CVv + o0 - DM), cb = *(const u32x4*)(CVc + o0 - DM);
#pragma unroll
            for (int j = 0; j < 4; ++j) { p2[2 * j] = bf_lo(va[j]) * bf_lo(ca[j]); p2[2 * j + 1] = bf_hi(va[j]) * bf_hi(ca[j]); p1[2 * j] = bf_lo(vb[j]) * bf_lo(cb[j]); p1[2 * j + 1] = bf_hi(vb[j]) * bf_hi(cb[j]); }
        }
#pragma unroll 4
        for (int t = 0; t < 16; ++t) {
            const size_t o = o0 + (size_t)t * DM;
            const u32x4 vv = *(const u32x4*)(CVv + o), cc = *(const u32x4*)(CVc + o), bb = *(const u32x4*)(CVb + o), zz = *(const u32x4*)(CVz + o);
            float y[8];
#pragma unroll
            for (int j = 0; j < 4; ++j) {
                const float c0 = bf_lo(vv[j]) * bf_lo(cc[j]), c1 = bf_hi(vv[j]) * bf_hi(cc[j]);
                const float z0 = bf_lo(zz[j]), z1 = bf_hi(zz[j]);
                y[2 * j] = bf_lo(bb[j]) * (w0[2 * j] * p2[2 * j] + w1[2 * j] * p1[2 * j] + w2[2 * j] * c0) * (z0 * fast_sigmoid(z0));
                y[2 * j + 1] = bf_hi(bb[j]) * (w0[2 * j + 1] * p2[2 * j + 1] + w1[2 * j + 1] * p1[2 * j + 1] + w2[2 * j + 1] * c1) * (z1 * fast_sigmoid(z1));
                p2[2 * j] = p1[2 * j]; p2[2 * j + 1] = p1[2 * j + 1]; p1[2 * j] = c0; p1[2 * j + 1] = c1;
            }
            u32x4 w; w.x = cvt_pk_bf16(y[0], y[1]); w.y = cvt_pk_bf16(y[2], y[3]); w.z = cvt_pk_bf16(y[4], y[5]); w.w = cvt_pk_bf16(y[6], y[7]);
            *(u32x4*)(YC + o) = w;
        }
    }
}

constexpr int KV_STRIDE = 160, KV_IMG = 256 * KV_STRIDE;
__device__ __forceinline__ void attn_phase(Frame& F, int l) {
    const bf16_t* Qg = (const bf16_t*)(F.ws + WS_Q); const bf16_t* Kg = (const bf16_t*)(F.ws + WS_K); const bf16_t* Vg = (const bf16_t*)(F.ws + WS_V);
    const bf16_t* SZ = (const bf16_t*)(F.ws + WS_SZ); bf16_t* OA = (bf16_t*)(F.ws + WS_OA);
    LAS unsigned char* Kl = F.lds; LAS unsigned char* Vl = F.lds + KV_IMG;
    const int lane = F.lane, w = F.wave, fr = lane & 15, fq = lane >> 4;
    constexpr int NUNITS = BATCH * NKVH * (SEQ / 128);
    const float NEG = -INFINITY;
    for (int un = F.vcu; un < NUNITS; un += F.G) {
        const int n = un & 31, hk = (un >> 5) & 3, b = un >> 7;
        const long band0 = (long)b * SEQ + 128 * (n - 1);
#pragma unroll
        for (int i = 0; i < 4; ++i) {
            const int idx = F.tid + 512 * i, r = idx >> 3, ch = idx & 7;
            u32x4 kv = (u32x4){0u, 0u, 0u, 0u}, vv = (u32x4){0u, 0u, 0u, 0u};
            if (n > 0 || r >= 128) { const size_t go = (size_t)(band0 + r) * KVW + hk * HD + ch * 8; kv = *(const u32x4*)(Kg + go); vv = *(const u32x4*)(Vg + go); }
            *(LAS u32x4*)(Kl + r * KV_STRIDE + ch * 16) = kv; *(LAS u32x4*)(Vl + r * KV_STRIDE + ch * 16) = vv;
        }
        const long qrow = (long)b * SEQ + 128 * n + 16 * w + fr;
        bf16x8 qf[4][2];
#pragma unroll
        for (int g = 0; g < 4; ++g)
#pragma unroll
            for (int s = 0; s < 2; ++s) qf[g][s] = *(const bf16x8*)(Qg + (size_t)qrow * DM + (hk * 4 + g) * HD + 32 * s + 8 * fq);
        __syncthreads();
        const LAS unsigned char* kbase = Kl + (16 * w + fr) * KV_STRIDE + 16 * fq;
        const LAS unsigned char* vbase = Vl + (16 * w + 4 * fq + (fr >> 2)) * KV_STRIDE + 8 * (fr & 3);
        const int t9 = (w + 9 > 15 ? 15 : w + 9) - w;
#pragma unroll 1
        for (int g = 0; g < 4; ++g) {
            const int h = hk * 4 + g;
            const float sink2 = F.sinks[l * NQH + h] * LOG2E;
            u32x2 szv[4];
#pragma unroll
            for (int dt = 0; dt < 4; ++dt) szv[dt] = *(const u32x2*)(SZ + (size_t)qrow * DM + h * HD + 16 * dt + 4 * fq);
            f32x4 st[9];
#pragma unroll
            for (int j = 0; j < 9; ++j) {
                const bf16x8 k0 = *(const LAS bf16x8*)(kbase + j * 16 * KV_STRIDE), k1 = *(const LAS bf16x8*)(kbase + j * 16 * KV_STRIDE + 64);
                f32x4 a = __builtin_amdgcn_mfma_f32_16x16x32_bf16(k0, qf[g][0], (f32x4){0.f, 0.f, 0.f, 0.f}, 0, 0, 0);
                st[j] = __builtin_amdgcn_mfma_f32_16x16x32_bf16(k1, qf[g][1], a, 0, 0, 0);
            }
#pragma unroll
            for (int i = 0; i < 4; ++i) { const int kk = 4 * fq + i; if (!(kk > fr)) st[0][i] = NEG; if (kk > fr) st[8][i] = NEG; }
            if (n == 0) {
#pragma unroll
                for (int j = 0; j < 8; ++j) if (w + j < 8) st[j] = (f32x4){NEG, NEG, NEG, NEG};
            }
            float mx = sink2;
#pragma unroll
            for (int j = 0; j < 9; ++j) mx = fmaxf(mx, fmaxf(fmaxf(st[j][0], st[j][1]), fmaxf(st[j][2], st[j][3])));
            mx = fmaxf(mx, __shfl_xor(mx, 16)); mx = fmaxf(mx, __shfl_xor(mx, 32));
            float sum = 0.f;
#pragma unroll
            for (int j = 0; j < 9; ++j)
#pragma unroll
                for (int i = 0; i < 4; ++i) { st[j][i] = __builtin_amdgcn_exp2f(st[j][i] - mx); sum += st[j][i]; }
            sum += __shfl_xor(sum, 16); sum += __shfl_xor(sum, 32);
            const float inv = 1.0f / (sum + __builtin_amdgcn_exp2f(sink2 - mx));
            f32x4 ot[4];
#pragma unroll
            for (int dt = 0; dt < 4; ++dt) ot[dt] = (f32x4){0.f, 0.f, 0.f, 0.f};
#pragma unroll
            for (int s = 0; s < 5; ++s) {
                u32x4 pw;
                pw.x = cvt_pk_bf16(st[2 * s][0], st[2 * s][1]); pw.y = cvt_pk_bf16(st[2 * s][2], st[2 * s][3]);
                if (s < 4) { pw.z = cvt_pk_bf16(st[2 * s + 1][0], st[2 * s + 1][1]); pw.w = cvt_pk_bf16(st[2 * s + 1][2], st[2 * s + 1][3]); } else { pw.z = 0u; pw.w = 0u; }
                const bf16x8 pf = __builtin_bit_cast(bf16x8, pw);
                const int off0 = (2 * s) * 16 * KV_STRIDE, off1 = (s < 4 ? (2 * s + 1) : t9) * 16 * KV_STRIDE;
#pragma unroll
                for (int dt = 0; dt < 4; ++dt) {
                    const s16x4 lo = __builtin_bit_cast(s16x4, __builtin_amdgcn_ds_read_tr16_b64_v4i16((LAS s16x4*)(vbase + off0 + 32 * dt)));
                    const s16x4 hi = __builtin_bit_cast(s16x4, __builtin_amdgcn_ds_read_tr16_b64_v4i16((LAS s16x4*)(vbase + off1 + 32 * dt)));
                    const bf16x8 vf = (bf16x8){lo[0], lo[1], lo[2], lo[3], hi[0], hi[1], hi[2], hi[3]};
                    ot[dt] = __builtin_amdgcn_mfma_f32_16x16x32_bf16(vf, pf, ot[dt], 0, 0, 0);
                }
            }
#pragma unroll
            for (int dt = 0; dt < 4; ++dt) {
                u32x2 o; o.x = cvt_pk_bf16(ot[dt][0] * inv * bf_lo(szv[dt].x), ot[dt][1] * inv * bf_hi(szv[dt].x)); o.y = cvt_pk_bf16(ot[dt][2] * inv * bf_lo(szv[dt].y), ot[dt][3] * inv * bf_hi(szv[dt].y));
                *(u32x2*)(OA + (size_t)qrow * DM + h * HD + 16 * dt + 4 * fq) = o;
            }
        }
        __syncthreads();
    }
}

#define XB_TMO      128
#define XB_XCNT(j)  (256  + 64 * (j))
#define XB_XSUB(j)  (1280 + 64 * (j))
#define XB_XGEN(j)  (2304 + 64 * (j))
#define XB_TOP      3328
#define XB_TOPGEN   3392
#define XCD_BAR_WORDS 3456
#define XB_SPIN_CAP (1u << 18)
__device__ __forceinline__ unsigned xb_ld(unsigned* p)              { return __hip_atomic_load(p, __ATOMIC_RELAXED, __HIP_MEMORY_SCOPE_AGENT); }
__device__ __forceinline__ unsigned xb_add(unsigned* p, unsigned v) { return __hip_atomic_fetch_add(p, v, __ATOMIC_RELAXED, __HIP_MEMORY_SCOPE_AGENT); }
__device__ __forceinline__ unsigned xb_xcc_id() { return (unsigned)__builtin_amdgcn_s_getreg((3 << 11) | 20) & 0xFu; }
#define XB_SPIN(cond, bar) do { unsigned _sp = 0; while (cond) { __builtin_amdgcn_s_sleep(1); \
    if ((++_sp & 255u) == 0u) { if (xb_ld(&(bar)[XB_TMO])) break; if (_sp > XB_SPIN_CAP) { atomicAdd(&(bar)[XB_TMO], 1u); break; } } } } while (0)
struct XcdBarrier { unsigned* bar; unsigned x; volatile LAS unsigned* st; };
__device__ __forceinline__ XcdBarrier xcd_barrier_post(unsigned* bar, volatile LAS unsigned* st) {
    XcdBarrier b; b.bar = bar; b.x = xb_xcc_id(); b.st = st;
    if (threadIdx.x == 0) (void)xb_add(&bar[XB_XCNT(b.x)], 1u);
    return b;
}
__device__ __forceinline__ void xcd_barrier_complete(unsigned* bar, unsigned x, unsigned& nloc, unsigned& nx) {
    const unsigned G = gridDim.x * gridDim.y * gridDim.z;
    unsigned sum, cnt, mine, sp = 0u;
    for (;;) {
        sum = 0u; cnt = 0u; mine = 0u;
#pragma unroll
        for (unsigned j = 0; j < 16; ++j) { const unsigned c = xb_ld(&bar[XB_XCNT(j)]); sum += c; cnt += (c > 0u) ? 1u : 0u; mine = (j == x) ? c : mine; }
        if (sum == G) break;
        __builtin_amdgcn_s_sleep(1);
        if ((++sp & 255u) == 0u) { if (xb_ld(&bar[XB_TMO])) break; if (sp > XB_SPIN_CAP) { atomicAdd(&bar[XB_TMO], 1u); break; } }
    }
    nloc = mine > 0u ? mine : 1u; nx = cnt > 0u ? cnt : 1u;
}
__device__ __forceinline__ void xcd_barrier(const XcdBarrier& b) {
    asm volatile("s_waitcnt vmcnt(0)" ::: "memory");
    __syncthreads();
    if (threadIdx.x == 0) {
        unsigned* bar = b.bar;
        __builtin_amdgcn_s_waitcnt(0);
        unsigned nloc = b.st[0], nx = b.st[1];
        if (nloc == 0u) { xcd_barrier_complete(bar, b.x, nloc, nx); b.st[0] = nloc; b.st[1] = nx; }
        const unsigned old = xb_add(&bar[XB_XSUB(b.x)], 1u);
        const unsigned gen = old / nloc;
        if (old + 1u == (gen + 1u) * nloc) {
            __builtin_amdgcn_fence(__ATOMIC_RELEASE, "agent");
            asm volatile("s_waitcnt vmcnt(0)" ::: "memory");
            const unsigned og = xb_add(&bar[XB_TOP], 1u);
            const unsigned tg = og / nx;
            if (og + 1u == (tg + 1u) * nx) xb_add(&bar[XB_TOPGEN], 1u);
            else XB_SPIN(xb_ld(&bar[XB_TOPGEN]) == tg, bar);
            __builtin_amdgcn_fence(__ATOMIC_ACQUIRE, "agent");
            xb_add(&bar[XB_XGEN(b.x)], 1u);
            asm volatile("s_waitcnt vmcnt(0)" ::: "memory");
        } else {
            XB_SPIN(xb_ld(&bar[XB_XGEN(b.x)]) == gen, bar);
            __builtin_amdgcn_fence(__ATOMIC_ACQUIRE, "agent");
            asm volatile("s_waitcnt vmcnt(0)" ::: "memory");
        }
    }
    __syncthreads();
}

struct Args { const float* in[11]; float* out; unsigned char* ws; int ph_lo, ph_hi; };
constexpr int NPHASES = 1 + 4 * DEPTH;

__global__ void __launch_bounds__(NWAVES * 64, 2) fwd_kernel(Args args) {
    extern __shared__ __attribute__((aligned(16))) unsigned char lds_raw[];
    const int lo = args.ph_lo, hi = args.ph_hi;
    volatile LAS unsigned* MISC = (volatile LAS unsigned*)((LAS unsigned char*)lds_raw + 131072 + 320);
    if (threadIdx.x < 32) MISC[threadIdx.x] = 0u;
    __syncthreads();
    XcdBarrier bar = xcd_barrier_post((unsigned*)(args.ws + WS_CTL), MISC + 8);
    for (int ph = lo; ph < hi; ++ph) {
        if (ph > lo) { if (ph == 1) cg::this_grid().sync(); else xcd_barrier(bar); }
        Frame F;
        F.lds = (LAS unsigned char*)lds_raw;
        { int t = threadIdx.x; asm volatile("" : "+v"(t)); F.tid = t; }
        F.lane = F.tid & 63; F.wave = __builtin_amdgcn_readfirstlane(F.tid >> 6);
        { int gsz = gridDim.x, bx = blockIdx.x; asm volatile("" : "+s"(gsz), "+s"(bx)); F.G = gsz; F.bx = bx; F.vcu = (F.G % 8 == 0) ? (bx % 8) * (F.G / 8) + bx / 8 : bx; }
        F.x = args.in[0]; F.norm_g = args.in[1]; F.w_in = args.in[2]; F.conv_w = args.in[3]; F.qng = args.in[4]; F.kng = args.in[5]; F.sinks = args.in[6];
        F.w_co = args.in[7]; F.w_ao = args.in[8]; F.gate_b = args.in[9]; F.w_out = args.in[10]; F.out = args.out;
        size_t wz = 0; asm volatile("" : "+s"(wz)); unsigned char* ws = args.ws + wz; F.ws = ws;
        float* rowss = (float*)(ws + WS_ROWSS);
        bf16_t* XB = (bf16_t*)(ws + WS_XB);
        if (ph == 0) { p0_prologue(F); if (PROBE_DUP & 1) p0_prologue(F); continue; }
        const int l = (ph - 1) >> 2, s = (ph - 1) & 3;
        unsigned char* wl = ws + WS_W + (size_t)l * W_LAYER;
        if (s == 0) {
            pg8::Gemm g{XB, (const bf16_t*)wl, XB, (const bf16_t*)wl, DM};
            pg8::StaticOrder S; S.init(M, NCOLS, F.G, F.bx, 1);
            EpiIn E{(bf16_t*)(ws + WS_CV), (bf16_t*)(ws + WS_Q), (bf16_t*)(ws + WS_K), (bf16_t*)(ws + WS_V), (bf16_t*)(ws + WS_SZ), (bf16_t*)(ws + WS_G),
                    rowss + (size_t)l * M, F.qng + l * HD, F.kng + l * HD, F.gate_b + l * 2 * DM};
            pg8::gemm_phase<EpiIn, true, true>(F.lds, F.tid, g, S, E);
            if (PROBE_DUP & 2) pg8::gemm_phase<EpiIn, true, true>(F.lds, F.tid, g, S, E);
        } else if (s == 1) {
            attn_phase(F, l); if (PROBE_DUP & 4) attn_phase(F, l);
            conv_phase(F, l); if (PROBE_DUP & 8) conv_phase(F, l);
        } else if (s == 2) {
            pg8::Gemm g{(const bf16_t*)(ws + WS_YC), (const bf16_t*)(wl + W_CO), (const bf16_t*)(ws + WS_OA), (const bf16_t*)(wl + W_AO), DM};
            pg8::StaticOrder S; S.init(M, DM, F.G, F.bx, 2);
            EpiMerge E{(const bf16_t*)(ws + WS_G), (bf16_t*)(ws + WS_MG)};
            pg8::gemm_phase<EpiMerge, true, true>(F.lds, F.tid, g, S, E);
            if (PROBE_DUP & 16) pg8::gemm_phase<EpiMerge, true, true>(F.lds, F.tid, g, S, E);
        } else {
            pg8::Gemm g{(const bf16_t*)(ws + WS_MG), (const bf16_t*)(wl + W_OUT), (const bf16_t*)(ws + WS_MG), (const bf16_t*)(wl + W_OUT), DM};
            pg8::StaticOrder S; S.init(M, DM, F.G, F.bx, 1);
            const bool lastl = (l == DEPTH - 1);
            EpiOut E{l == 0 ? F.x : F.out, F.out, XB, lastl ? nullptr : rowss + (size_t)(l + 1) * M};
            if (PROBE_DUP & 32) { EpiOut E2{l == 0 ? F.x : F.out, (float*)(ws + WS_CV), XB, nullptr}; pg8::gemm_phase<EpiOut, true, true>(F.lds, F.tid, g, S, E2); }
            pg8::gemm_phase<EpiOut, true, true>(F.lds, F.tid, g, S, E);
        }
    }
}

extern "C" void kernel_launch(void* const* d_in, const int* in_sizes, int n_in, void* d_out, int out_size, void* d_ws, size_t ws_size, hipStream_t stream) {
    static int grid = 0;
    if (grid == 0) {
        if (n_in != 11 || in_sizes[0] != M * DM || out_size != M * DM || ws_size < WS_END) {
            fprintf(stderr, "kernel_launch: unexpected shapes: n_in %d in0 %d out %d ws %zu (need %zu)\n", n_in, n_in > 0 ? in_sizes[0] : -1, out_size, ws_size, (size_t)WS_END); grid = -1; return; }
        int dev = 0, cus = 0, per_cu = 0;
        hipGetDevice(&dev); hipDeviceGetAttribute(&cus, hipDeviceAttributeMultiprocessorCount, dev);
        if (hipFuncSetAttribute((const void*)fwd_kernel, hipFuncAttributeMaxDynamicSharedMemorySize, LDS_BYTES) != hipSuccess) { fprintf(stderr, "kernel_launch: hipFuncSetAttribute failed\n"); grid = -1; return; }
        if (hipOccupancyMaxActiveBlocksPerMultiprocessor(&per_cu, (const void*)fwd_kernel, NWAVES * 64, LDS_BYTES) != hipSuccess || per_cu < 1) { fprintf(stderr, "kernel_launch: occupancy query says %d\n", per_cu); per_cu = 1; }
        (void)hipGetLastError();
        grid = cus * 1;
        fprintf(stderr, "kernel_launch: grid %d (cus %d, per_cu %d)\n", grid, cus, per_cu);
    }
    if (grid < 0) return;
    Args a{};
    for (int i = 0; i < 11; ++i) a.in[i] = (const float*)d_in[i];
    a.out = (float*)d_out; a.ws = (unsigned char*)d_ws;
    if (hipMemsetAsync((char*)d_ws + WS_CTL, 0, CTL_BYTES, stream) != hipSuccess) { fprintf(stderr, "kernel_launch: memset failed\n"); return; }
#if MK_ONE_LAUNCH
    a.ph_lo = 0; a.ph_hi = NPHASES;
    void* kargs[] = {&a};
    hipError_t e = hipLaunchCooperativeKernel((const void*)fwd_kernel, dim3(grid), dim3(NWAVES * 64), kargs, LDS_BYTES, stream);
    if (e != hipSuccess) fprintf(stderr, "kernel_launch: cooperative launch failed: %s (grid %d)\n", hipGetErrorString(e), grid);
#else
    for (int p = 0; p < NPHASES; ++p) { a.ph_lo = p; a.ph_hi = p + 1; hipLaunchKernelGGL(fwd_kernel, dim3(grid), dim3(NWAVES * 64), LDS_BYTES, stream, a); }
#endif
}
```

```cpp
#include <hip/hip_runtime.h>
#include <hip/hip_cooperative_groups.h>
#include <cstdio>
#include <cstdint>
namespace cg = cooperative_groups;

#ifndef PROBE_DUP
#define PROBE_DUP 0
#endif
#ifndef MK_ONE_LAUNCH
#define MK_ONE_LAUNCH 1
#endif

#define LAS __attribute__((address_space(3)))
typedef unsigned short bf16_t;
typedef short bf16x8 __attribute__((ext_vector_type(8)));
typedef short s16x4 __attribute__((ext_vector_type(4)));
typedef float f32x4 __attribute__((ext_vector_type(4)));
typedef unsigned u32x4 __attribute__((ext_vector_type(4)));
typedef unsigned u32x2 __attribute__((ext_vector_type(2)));

constexpr int DM = 1024, BATCH = 4, SEQ = 4096, DEPTH = 4, M = BATCH * SEQ;
constexpr int NQH = 16, NKVH = 4, HD = 64, KVW = NKVH * HD;
constexpr int NCOLS = 4 * DM + DM + 2 * KVW + DM + 2 * DM;
constexpr float EPS = 1e-6f;
constexpr float LOG2E = 1.4426950408889634f;
constexpr float QSCALE = 0.125f * LOG2E;

constexpr size_t MiB = 1u << 20;
constexpr size_t WS_ROWSS = 0;
constexpr size_t WS_CTL = 512 * 1024, CTL_BYTES = 16384;
constexpr size_t WS_W = 1 * MiB;
constexpr size_t W_LAYER = 23 * MiB, W_CO = 17 * MiB, W_AO = 19 * MiB, W_OUT = 21 * MiB;
constexpr size_t WS_XB = 96 * MiB;
constexpr size_t WS_CV = 128 * MiB;
constexpr size_t WS_Q = 256 * MiB;
constexpr size_t WS_K = 288 * MiB;
constexpr size_t WS_V = 296 * MiB;
constexpr size_t WS_SZ = 304 * MiB;
constexpr size_t WS_G = 336 * MiB;
constexpr size_t WS_YC = 400 * MiB;
constexpr size_t WS_OA = 432 * MiB;
constexpr size_t WS_MG = 464 * MiB;
constexpr size_t WS_END = 496 * MiB;

constexpr int NWAVES = 8;
constexpr int LDS_BYTES = 147456;

typedef float f32x2_t __attribute__((ext_vector_type(2))); typedef __bf16 bf16x2_t __attribute__((ext_vector_type(2)));
__device__ __forceinline__ unsigned cvt_pk_bf16(float lo, float hi) { f32x2_t v = {lo, hi}; bf16x2_t b = __builtin_convertvector(v, bf16x2_t); return __builtin_bit_cast(unsigned, b); }
__device__ __forceinline__ float bf_lo(unsigned u) { return __uint_as_float(u << 16); }
__device__ __forceinline__ float bf_hi(unsigned u) { return __uint_as_float(u & 0xffff0000u); }
__device__ __forceinline__ float fast_sigmoid(float v) { return __builtin_amdgcn_rcpf(1.0f + __builtin_amdgcn_exp2f(-v * LOG2E)); }

namespace pg8 {
constexpr int BM = 256, BK = 64, HALF = 128, HTB = HALF * BK * 2, STAGE_BYTES = 8 * HTB, NXCD = 8, WGM = 8;
__host__ __device__ __forceinline__ int lds_byte(int r, int c) { const int st = (r >> 4) * 2 + (c >> 5), rr = r & 15, cc = c & 31, ob = rr * 64 + cc * 2; return st * 1024 + (ob ^ (((ob >> 9) & 1) << 5)); }
__host__ __device__ __forceinline__ void stage_rc(int b, int& R, int& C) { const int st = b / 1024, sb = b % 1024, swz = sb ^ (((sb >> 9) & 1) << 5); R = (st >> 1) * 16 + swz / 64; C = (st & 1) * 32 + (swz % 64) / 2; }
__host__ __device__ __forceinline__ int perm32(int rho) { const int n = rho >> 4, i = rho & 15; return 8 * (i >> 2) + 4 * n + (i & 3); }

struct Unit { int pm, pn, seg; };
struct Gemm { const bf16_t* A0; const bf16_t* B0; const bf16_t* A1; const bf16_t* B1; int K; };

struct StaticOrder {
    int nM, nN, nwg, G, c, nseg;
    __device__ void init(int M_, int N_, int G_, int c_, int nseg_) { nM = M_ / BM; nN = N_ / BM; nwg = nM * nN; G = G_; c = c_; nseg = nseg_; }
    __device__ bool next(int i, Unit& u) const {
        int ti = i; u.seg = 0;
        if (nseg == 2) { ti = i >> 1; u.seg = i & 1; }
        const long L = (long)ti * G + c; if (L >= nwg) return false;
        int wgid = (int)L; { const int q = nwg / NXCD, r = nwg % NXCD, xcd = wgid % NXCD, off = wgid / NXCD; wgid = (xcd < r ? xcd * (q + 1) : r * (q + 1) + (xcd - r) * q) + off; }
        const int nig = WGM * nN, gid = wgid / nig, fm = gid * WGM, gsz = (nM - fm) < WGM ? (nM - fm) : WGM;
        u.pm = fm + ((wgid % nig) % gsz); u.pn = (wgid % nig) / gsz; return true;
    }
};

typedef f32x4 Acc[2][2][4][2];

template <class Epi, bool ALIGN_EPI, bool SP2>
__device__ __forceinline__ void gemm_phase(LAS unsigned char* lds, const int tid, const Gemm g, const StaticOrder& S, const Epi& E) {
    const int wid = __builtin_amdgcn_readfirstlane(tid >> 6), lane = tid & 63, wr = wid >> 2, wc = wid & 3, fr = lane & 15, fq = lane >> 4;
    const int K = g.K, nt = K / BK;
    unsigned voffA[2], voffB[2];
#pragma unroll
    for (int i = 0; i < 2; ++i) { int R, C; stage_rc(tid * 16 + i * 8192, R, C); const int Rb = Epi::PERM ? ((R & ~31) + perm32(R & 31)) : R;
        voffA[i] = (unsigned)(R * K + C) * 2u; voffB[i] = (unsigned)(Rb * K + C) * 2u; }
    const size_t kstep = (size_t)(BK * 2);
    const size_t hstep = (size_t)HALF * K * 2;
    const size_t tstep = 2 * hstep;
    const unsigned ldsw = (unsigned)wid * 1024u;
    const int aoff = lds_byte(wr * 64 + fr, fq * 8), boff = lds_byte(wc * 32 + fr, fq * 8);
#define PG8_SA(b, h) (((b) * 2 + (h)) * HTB)
#define PG8_SB(b, h) ((4 + (b) * 2 + (h)) * HTB)
#define PG8_STAGE(bufoff, gbase, voff) do { _Pragma("unroll") for (int _i = 0; _i < 2; ++_i) \
        __builtin_amdgcn_global_load_lds((const unsigned*)((const char*)(gbase) + (voff)[_i]), (LAS unsigned*)(lds + (bufoff) + ldsw + _i * 8192), 16, 0, 0); } while (0)
#define PG8_LDA(dst, b, h) do { _Pragma("unroll") for (int m = 0; m < 4; ++m) _Pragma("unroll") for (int k = 0; k < 2; ++k) dst[m][k] = *(const LAS bf16x8*)(lds + PG8_SA(b, h) + aoff + m * 2048 + k * 1024); } while (0)
#define PG8_LDB(dst, b, h) do { _Pragma("unroll") for (int n = 0; n < 2; ++n) _Pragma("unroll") for (int k = 0; k < 2; ++k) dst[n][k] = *(const LAS bf16x8*)(lds + PG8_SB(b, h) + boff + n * 2048 + k * 1024); } while (0)
#define PG8_MMA(ai, bj, At, Bt) do { __builtin_amdgcn_s_setprio(1); _Pragma("unroll") for (int m = 0; m < 4; ++m) _Pragma("unroll") for (int n = 0; n < 2; ++n) _Pragma("unroll") for (int k = 0; k < 2; ++k) \
        acc[ai][bj][m][n] = __builtin_amdgcn_mfma_f32_16x16x32_bf16(Bt[n][k], At[m][k], acc[ai][bj][m][n], 0, 0, 0); __builtin_amdgcn_s_setprio(0); } while (0)
#define PG8_WAIT_V(n) asm volatile("s_waitcnt vmcnt(" #n ")" ::: "memory")
#define PG8_WAIT_L(n) asm volatile("s_waitcnt lgkmcnt(" #n ")" ::: "memory")
#define PG8_BAR __builtin_amdgcn_s_barrier()
#define PG8_SCHED __builtin_amdgcn_sched_barrier(0)
    Unit cur, nxt; int ui = 0;
    if (!S.next(0, cur)) return;
    Acc acc;
#pragma unroll
    for (int a = 0; a < 2; ++a)
#pragma unroll
        for (int b = 0; b < 2; ++b)
#pragma unroll
            for (int m = 0; m < 4; ++m)
#pragma unroll
                for (int n = 0; n < 2; ++n) acc[a][b][m][n] = (f32x4){0.f, 0.f, 0.f, 0.f};
    bf16x8 At[4][2], B0[2][2], B1[2][2];
    const char* cA = (const char*)(cur.seg ? g.A1 : g.A0) + (size_t)cur.pm * tstep; const char* cB = (const char*)(cur.seg ? g.B1 : g.B0) + (size_t)cur.pn * tstep;
    if constexpr (SP2) {
        PG8_STAGE(PG8_SB(0, 0), cB, voffB); PG8_STAGE(PG8_SB(0, 1), cB + hstep, voffB); PG8_STAGE(PG8_SA(0, 0), cA, voffA); PG8_STAGE(PG8_SA(0, 1), cA + hstep, voffA);
        if (wr == 1) PG8_BAR;
        PG8_WAIT_V(2); PG8_BAR;
        PG8_STAGE(PG8_SB(1, 0), cB + kstep, voffB); PG8_STAGE(PG8_SA(1, 0), cA + kstep, voffA); PG8_STAGE(PG8_SB(1, 1), cB + hstep + kstep, voffB);
        PG8_WAIT_V(6); PG8_BAR;
    } else {
        PG8_STAGE(PG8_SB(0, 0), cB, voffB); PG8_STAGE(PG8_SA(0, 0), cA, voffA); PG8_STAGE(PG8_SB(0, 1), cB + hstep, voffB); PG8_STAGE(PG8_SA(0, 1), cA + hstep, voffA);
        if (wr == 1) PG8_BAR;
        PG8_WAIT_V(4); PG8_BAR;
        PG8_STAGE(PG8_SB(1, 0), cB + kstep, voffB); PG8_STAGE(PG8_SA(1, 0), cA + kstep, voffA); PG8_STAGE(PG8_SB(1, 1), cB + hstep + kstep, voffB);
        PG8_WAIT_V(6); PG8_BAR;
    }
    for (;;) {
        const bool has_next = S.next(ui + 1, nxt);
        const char* nA = has_next ? (const char*)(nxt.seg ? g.A1 : g.A0) + (size_t)nxt.pm * tstep : cA; const char* nB = has_next ? (const char*)(nxt.seg ? g.B1 : g.B0) + (size_t)nxt.pn * tstep : cB;
        for (int t = 0; t < nt; t += 2) {
            const bool last = (t == nt - 2);
            const char* a1 = cA + (size_t)(t + 1) * kstep;
            const char* a2 = last ? nA : cA + (size_t)(t + 2) * kstep; const char* b2 = last ? nB : cB + (size_t)(t + 2) * kstep;
            const char* a3 = a2 + kstep; const char* b3 = b2 + kstep;
            if constexpr (SP2) {
            PG8_LDB(B0, 0, 0); PG8_LDB(B1, 0, 1); PG8_SCHED; PG8_LDA(At, 0, 0); PG8_STAGE(PG8_SA(1, 1), a1 + hstep, voffA);
            PG8_WAIT_V(8); PG8_WAIT_L(0); PG8_BAR; PG8_MMA(0, 0, At, B0); PG8_MMA(0, 1, At, B1); PG8_BAR; PG8_SCHED;
            PG8_LDA(At, 0, 1); PG8_STAGE(PG8_SB(0, 0), b2, voffB); PG8_STAGE(PG8_SB(0, 1), b2 + hstep, voffB); PG8_STAGE(PG8_SA(0, 0), a2, voffA);
            PG8_WAIT_V(8); PG8_WAIT_L(0); PG8_BAR; PG8_MMA(1, 0, At, B0); PG8_MMA(1, 1, At, B1); PG8_BAR; PG8_SCHED;
            PG8_LDB(B0, 1, 0); PG8_LDB(B1, 1, 1); PG8_SCHED; PG8_LDA(At, 1, 0); PG8_STAGE(PG8_SA(0, 1), a2 + hstep, voffA);
            PG8_WAIT_V(8); PG8_WAIT_L(0); PG8_BAR; PG8_MMA(0, 0, At, B0); PG8_MMA(0, 1, At, B1); PG8_BAR; PG8_SCHED;
            PG8_LDA(At, 1, 1); PG8_STAGE(PG8_SB(1, 0), b3, voffB); PG8_STAGE(PG8_SB(1, 1), b3 + hstep, voffB); PG8_STAGE(PG8_SA(1, 0), a3, voffA);
            PG8_WAIT_V(8); PG8_WAIT_L(0); PG8_BAR; PG8_MMA(1, 0, At, B0); PG8_MMA(1, 1, At, B1); PG8_BAR; PG8_SCHED;
            } else {
            PG8_LDB(B0, 0, 0); PG8_SCHED; PG8_LDA(At, 0, 0); PG8_STAGE(PG8_SA(1, 1), a1 + hstep, voffA);
            PG8_WAIT_L(8); PG8_BAR; PG8_WAIT_L(0); PG8_MMA(0, 0, At, B0); PG8_BAR; PG8_SCHED;
            PG8_LDB(B1, 0, 1); PG8_STAGE(PG8_SB(0, 0), b2, voffB);
            PG8_BAR; PG8_WAIT_L(0); PG8_MMA(0, 1, At, B1); PG8_BAR;
            PG8_LDA(At, 0, 1); PG8_STAGE(PG8_SA(0, 0), a2, voffA);
            PG8_BAR; PG8_WAIT_L(0); PG8_MMA(1, 0, At, B0); PG8_BAR; PG8_SCHED;
            PG8_STAGE(PG8_SB(0, 1), b2 + hstep, voffB);
            PG8_WAIT_V(6); PG8_BAR; PG8_MMA(1, 1, At, B1); PG8_BAR;
            PG8_LDB(B0, 1, 0); PG8_SCHED; PG8_LDA(At, 1, 0); PG8_STAGE(PG8_SA(0, 1), a2 + hstep, voffA);
            PG8_WAIT_L(8); PG8_BAR; PG8_WAIT_L(0); PG8_MMA(0, 0, At, B0); PG8_BAR; PG8_SCHED;
            PG8_LDB(B1, 1, 1); PG8_STAGE(PG8_SB(1, 0), b3, voffB);
            PG8_BAR; PG8_WAIT_L(0); PG8_MMA(0, 1, At, B1); PG8_BAR;
            PG8_LDA(At, 1, 1); PG8_STAGE(PG8_SA(1, 0), a3, voffA);
            PG8_BAR; PG8_WAIT_L(0); PG8_MMA(1, 0, At, B0); PG8_BAR; PG8_SCHED;
            PG8_STAGE(PG8_SB(1, 1), b3 + hstep, voffB);
            PG8_WAIT_V(6); PG8_BAR; PG8_MMA(1, 1, At, B1); PG8_BAR;
            }
        }
        if constexpr (ALIGN_EPI) { if (wr == 0) PG8_BAR; }
        bool keep = false;
        if constexpr (Epi::TWO_SEG) { if (cur.seg == 0) { E.mid(acc, cur, wr, wc, fr, fq); keep = true; } else E(acc, cur, wr, wc, fr, fq); }
        else E(acc, cur, wr, wc, fr, fq);
        if (!has_next) break;
        if (!keep) {
#pragma unroll
        for (int a = 0; a < 2; ++a)
#pragma unroll
            for (int b = 0; b < 2; ++b)
#pragma unroll
                for (int m = 0; m < 4; ++m)
#pragma unroll
                    for (int n = 0; n < 2; ++n) acc[a][b][m][n] = (f32x4){0.f, 0.f, 0.f, 0.f};
        }
        cur = nxt; cA = nA; cB = nB; ++ui;
        if constexpr (ALIGN_EPI) { if (wr == 1) PG8_BAR; }
    }
    PG8_WAIT_V(0);
    if constexpr (!ALIGN_EPI) { if (wr == 0) PG8_BAR; }
    PG8_BAR;
#undef PG8_SA
#undef PG8_SB
#undef PG8_STAGE
#undef PG8_LDA
#undef PG8_LDB
#undef PG8_MMA
#undef PG8_WAIT_V
#undef PG8_WAIT_L
#undef PG8_BAR
#undef PG8_SCHED
}
}

struct EpiIn {
    static constexpr bool PERM = true, TWO_SEG = false;
    bf16_t *CV, *Q, *Kb, *Vb, *SZ, *G; const float *rowss, *qg, *kg, *gate_b;
    __device__ __forceinline__ void store8(bf16_t* p, const f32x4& v0, const f32x4& v1) const {
        u32x4 w; w.x = cvt_pk_bf16(v0[0], v0[1]); w.y = cvt_pk_bf16(v0[2], v0[3]); w.z = cvt_pk_bf16(v1[0], v1[1]); w.w = cvt_pk_bf16(v1[2], v1[3]); *(u32x4*)p = w; }
    __device__ __forceinline__ void operator()(pg8::Acc& acc, const pg8::Unit& u, int wr, int wc, int fr, int fq) const {
        const int row0 = u.pm * 256 + wr * 64 + fr; const int pn = u.pn;
        float rs[2][4];
#pragma unroll
        for (int ai = 0; ai < 2; ++ai)
#pragma unroll
            for (int m = 0; m < 4; ++m) rs[ai][m] = 1.0f / sqrtf(rowss[row0 + ai * 128 + m * 16] * (1.0f / DM) + EPS);
        if (pn < 16 || pn == 21 || (pn >= 22 && pn < 26)) {
            bf16_t* base; int ld, colt; const bool act = (pn >= 22);
            if (pn < 16) { base = CV + (size_t)(pn >> 2) * ((size_t)M * DM); ld = DM; colt = (pn & 3) * 256; }
            else if (pn == 21) { base = Vb; ld = KVW; colt = 0; }
            else { base = SZ; ld = DM; colt = (pn - 22) * 256; }
            const int col0 = colt + wc * 32 + 8 * fq;
#pragma unroll
            for (int ai = 0; ai < 2; ++ai)
#pragma unroll
                for (int m = 0; m < 4; ++m) { bf16_t* rowp = base + (size_t)(row0 + ai * 128 + m * 16) * ld + col0; const float r = rs[ai][m];
#pragma unroll
                    for (int bj = 0; bj < 2; ++bj) { f32x4 v0 = acc[ai][bj][m][0] * r, v1 = acc[ai][bj][m][1] * r;
                        if (act) {
#pragma unroll
                            for (int i = 0; i < 4; ++i) { v0[i] = v0[i] * fast_sigmoid(v0[i]); v1[i] = v1[i] * fast_sigmoid(v1[i]); } }
                        store8(rowp + bj * 128, v0, v1); } }
        } else if (pn >= 26) {
            const int colt = (pn - 26) * 256, col0 = colt + wc * 32 + 8 * fq;
            f32x4 bv[2][2];
#pragma unroll
            for (int bj = 0; bj < 2; ++bj)
#pragma unroll
                for (int n = 0; n < 2; ++n) bv[bj][n] = *(const f32x4*)(gate_b + col0 + bj * 128 + 4 * n);
#pragma unroll
            for (int ai = 0; ai < 2; ++ai)
#pragma unroll
                for (int m = 0; m < 4; ++m) { bf16_t* rowp = G + (size_t)(row0 + ai * 128 + m * 16) * (2 * DM) + col0; const float r = rs[ai][m];
#pragma unroll
                    for (int bj = 0; bj < 2; ++bj) { f32x4 v0 = acc[ai][bj][m][0] * r + bv[bj][0], v1 = acc[ai][bj][m][1] * r + bv[bj][1];
#pragma unroll
                        for (int i = 0; i < 4; ++i) { v0[i] = fast_sigmoid(v0[i]); v1[i] = fast_sigmoid(v1[i]); }
                        store8(rowp + bj * 128, v0, v1); } }
        } else {
            const bool isq = pn < 20; bf16_t* base = isq ? Q : Kb; const int ld = isq ? DM : KVW, colt = isq ? (pn - 16) * 256 : 0;
            const float* gp = isq ? qg : kg; const float sc = isq ? QSCALE : 1.0f;
            f32x4 gv[2][2];
#pragma unroll
            for (int bj = 0; bj < 2; ++bj)
#pragma unroll
                for (int n = 0; n < 2; ++n) gv[bj][n] = *(const f32x4*)(gp + 32 * bj + 8 * fq + 4 * n) * sc;
            const int col0 = colt + wc * 64 + 8 * fq;
#pragma unroll
            for (int ai = 0; ai < 2; ++ai)
#pragma unroll
                for (int m = 0; m < 4; ++m) { bf16_t* rowp = base + (size_t)(row0 + ai * 128 + m * 16) * ld + col0; const float r = rs[ai][m];
                    f32x4 v[2][2]; float ss = 0.f;
#pragma unroll
                    for (int bj = 0; bj < 2; ++bj)
#pragma unroll
                        for (int n = 0; n < 2; ++n) { v[bj][n] = acc[ai][bj][m][n] * r; ss += (v[bj][n][0] * v[bj][n][0] + v[bj][n][1] * v[bj][n][1]) + (v[bj][n][2] * v[bj][n][2] + v[bj][n][3] * v[bj][n][3]); }
                    ss += __shfl_xor(ss, 16); ss += __shfl_xor(ss, 32);
                    const float rq = 1.0f / sqrtf(ss * (1.0f / HD) + EPS);
#pragma unroll
                    for (int bj = 0; bj < 2; ++bj) store8(rowp + bj * 32, v[bj][0] * rq * gv[bj][0], v[bj][1] * rq * gv[bj][1]); }
        }
    }
};

struct EpiMerge {
    static constexpr bool PERM = true, TWO_SEG = true;
    const bf16_t* G; bf16_t* MG;
    __device__ __forceinline__ void mid(pg8::Acc& acc, const pg8::Unit& u, int wr, int wc, int fr, int fq) const {
        const int row0 = u.pm * 256 + wr * 64 + fr, col0 = u.pn * 256 + wc * 32 + 8 * fq;
#pragma unroll
        for (int ai = 0; ai < 2; ++ai)
#pragma unroll
            for (int m = 0; m < 4; ++m) { const bf16_t* gp = G + (size_t)(row0 + ai * 128 + m * 16) * (2 * DM) + col0;
#pragma unroll
                for (int bj = 0; bj < 2; ++bj) { const u32x4 a = *(const u32x4*)(gp + bj * 128), b = *(const u32x4*)(gp + DM + bj * 128);
#pragma unroll
                    for (int j = 0; j < 4; ++j) { const float r0 = bf_lo(a[j]) * __builtin_amdgcn_rcpf(fmaxf(bf_lo(b[j]), 1e-30f)), r1 = bf_hi(a[j]) * __builtin_amdgcn_rcpf(fmaxf(bf_hi(b[j]), 1e-30f));
                        acc[ai][bj][m][j >> 1][(j & 1) * 2] *= r0; acc[ai][bj][m][j >> 1][(j & 1) * 2 + 1] *= r1; } } }
    }
    __device__ __forceinline__ void operator()(pg8::Acc& acc, const pg8::Unit& u, int wr, int wc, int fr, int fq) const {
        const int row0 = u.pm * 256 + wr * 64 + fr, col0 = u.pn * 256 + wc * 32 + 8 * fq;
#pragma unroll
        for (int ai = 0; ai < 2; ++ai)
#pragma unroll
            for (int m = 0; m < 4; ++m) { const size_t ro = (size_t)(row0 + ai * 128 + m * 16); const bf16_t* gp = G + ro * (2 * DM) + DM + col0; bf16_t* op = MG + ro * DM + col0;
#pragma unroll
                for (int bj = 0; bj < 2; ++bj) { const u32x4 b = *(const u32x4*)(gp + bj * 128); u32x4 w;
#pragma unroll
                    for (int j = 0; j < 4; ++j) w[j] = cvt_pk_bf16(acc[ai][bj][m][j >> 1][(j & 1) * 2] * bf_lo(b[j]), acc[ai][bj][m][j >> 1][(j & 1) * 2 + 1] * bf_hi(b[j]));
                    *(u32x4*)(op + bj * 128) = w; } }
    }
};

struct EpiOut {
    static constexpr bool PERM = false, TWO_SEG = false;
    const float* xin; float* xout; bf16_t* XB; float* rowss_next;
    __device__ __forceinline__ void operator()(pg8::Acc& acc, const pg8::Unit& u, int wr, int wc, int fr, int fq) const {
        const int row0 = u.pm * 256 + wr * 64 + fr, col0 = u.pn * 256 + wc * 32 + 4 * fq;
#pragma unroll
        for (int ai = 0; ai < 2; ++ai)
#pragma unroll
            for (int m = 0; m < 4; ++m) { const size_t off = (size_t)(row0 + ai * 128 + m * 16) * DM + col0; float ss = 0.f;
#pragma unroll
                for (int bj = 0; bj < 2; ++bj)
#pragma unroll
                    for (int n = 0; n < 2; ++n) { const f32x4 xv = *(const f32x4*)(xin + off + bj * 128 + n * 16); const f32x4 o = xv + acc[ai][bj][m][n];
                        *(f32x4*)(xout + off + bj * 128 + n * 16) = o; ss += (o[0] * o[0] + o[1] * o[1]) + (o[2] * o[2] + o[3] * o[3]);
                        if (rowss_next) { u32x2 w; w.x = cvt_pk_bf16(o[0], o[1]); w.y = cvt_pk_bf16(o[2], o[3]); *(u32x2*)(XB + off + bj * 128 + n * 16) = w; } }
                if (rowss_next) { ss += __shfl_xor(ss, 16); ss += __shfl_xor(ss, 32); if (fq == 0) atomicAdd(rowss_next + row0 + ai * 128 + m * 16, ss); } }
    }
};

struct Frame {
    LAS unsigned char* lds; int tid, lane, wave, vcu, G, bx;
    const float *x, *norm_g, *w_in, *conv_w, *qng, *kng, *sinks, *w_co, *w_ao, *gate_b, *w_out; float* out; unsigned char* ws;
};
__device__ __forceinline__ float wave_sum(float v) {
#pragma unroll
    for (int o = 1; o < 64; o <<= 1) v += __shfl_xor(v, o);
    return v;
}
__device__ __forceinline__ void p0_transpose_item(const float* W, int K, int N, bf16_t* WT, const float* gk, int plo, int phi, LAS float* scr, int item, int lane) {
    const int nblk = N / 32, kb = item / nblk, nb = item % nblk, k0 = 64 * kb, n0 = 32 * nb;
#pragma unroll 8
    for (int i = 0; i < 32; ++i) { const int kk = 2 * i + (lane >> 5); float w = W[(size_t)(k0 + kk) * N + n0 + (lane & 31)]; if (gk) w *= gk[k0 + kk]; scr[kk * 33 + (lane & 31)] = w; }
    asm volatile("s_waitcnt lgkmcnt(0)" ::: "memory");
    int d0 = n0;
    if (n0 >= plo && n0 < phi) { const int t = n0 & 255, wc_ = t >> 6, bj_ = (t >> 5) & 1; d0 = (n0 & ~255) + 128 * bj_ + 32 * wc_; }
    const int c = lane & 7;
#pragma unroll
    for (int j = 0; j < 4; ++j) { const int n = (lane >> 3) + 8 * j; const LAS float* s = scr + (8 * c) * 33 + n;
        u32x4 o; o.x = cvt_pk_bf16(s[0 * 33], s[1 * 33]); o.y = cvt_pk_bf16(s[2 * 33], s[3 * 33]); o.z = cvt_pk_bf16(s[4 * 33], s[5 * 33]); o.w = cvt_pk_bf16(s[6 * 33], s[7 * 33]);
        *(u32x4*)(WT + (size_t)(d0 + n) * K + k0 + 8 * c) = o; }
    asm volatile("s_waitcnt lgkmcnt(0)" ::: "memory");
}
__device__ __forceinline__ void p0_prologue(Frame& F) {
    LAS float* scr = (LAS float*)(F.lds + F.wave * 16384);
    const int gw = F.vcu * NWAVES + F.wave, NGW = F.G * NWAVES;
    constexpr int I_IN = (DM / 64) * (NCOLS / 32), I_SQ = (DM / 64) * (DM / 32), I_L = I_IN + 3 * I_SQ;
    for (int it = gw; it < DEPTH * I_L; it += NGW) {
        const int l = it / I_L; int r = it - l * I_L;
        unsigned char* wl = F.ws + WS_W + (size_t)l * W_LAYER;
        if (r < I_IN) { p0_transpose_item(F.w_in + (size_t)l * DM * NCOLS, DM, NCOLS, (bf16_t*)wl, F.norm_g + l * DM, 4 * DM, 4 * DM + DM + KVW, scr, r, F.lane); continue; } r -= I_IN;
        if (r < I_SQ) { p0_transpose_item(F.w_co + (size_t)l * DM * DM, DM, DM, (bf16_t*)(wl + W_CO), nullptr, 0, 0, scr, r, F.lane); continue; } r -= I_SQ;
        if (r < I_SQ) { p0_transpose_item(F.w_ao + (size_t)l * DM * DM, DM, DM, (bf16_t*)(wl + W_AO), nullptr, 0, 0, scr, r, F.lane); continue; } r -= I_SQ;
        p0_transpose_item(F.w_out + (size_t)l * DM * DM, DM, DM, (bf16_t*)(wl + W_OUT), nullptr, 0, 0, scr, r, F.lane);
    }
    float* rowss = (float*)(F.ws + WS_ROWSS); bf16_t* XB = (bf16_t*)(F.ws + WS_XB);
    for (int m = gw; m < M; m += NGW) {
        const f32x4* xr = (const f32x4*)(F.x + (size_t)m * DM) + F.lane; f32x4 v[4]; float s = 0.f;
#pragma unroll
        for (int j = 0; j < 4; ++j) { v[j] = xr[64 * j]; s += (v[j].x * v[j].x + v[j].y * v[j].y) + (v[j].z * v[j].z + v[j].w * v[j].w); }
        s = wave_sum(s);
        u32x2* o8 = (u32x2*)(XB + (size_t)m * DM) + F.lane;
#pragma unroll
        for (int j = 0; j < 4; ++j) { u32x2 w; w.x = cvt_pk_bf16(v[j].x, v[j].y); w.y = cvt_pk_bf16(v[j].z, v[j].w); o8[64 * j] = w; }
        if (F.lane == 0) rowss[m] = s;
        if (F.lane >= 1 && F.lane < DEPTH) rowss[(size_t)F.lane * M + m] = 0.f;
    }
}

__device__ __forceinline__ void conv_phase(Frame& F, int l) {
    const bf16_t* CVv = (const bf16_t*)(F.ws + WS_CV); const bf16_t* CVb = CVv + (size_t)M * DM; const bf16_t* CVc = CVb + (size_t)M * DM; const bf16_t* CVz = CVc + (size_t)M * DM;
    bf16_t* YC = (bf16_t*)(F.ws + WS_YC);
    const int cg8 = F.tid & 127, sub = F.tid >> 7;
    const float* cw = F.conv_w + (size_t)l * 3 * DM + cg8 * 8;
    float w0[8], w1[8], w2[8];
#pragma unroll
    for (int j = 0; j < 8; ++j) { w0[j] = cw[j]; w1[j] = cw[DM + j]; w2[j] = cw[2 * DM + j]; }
    for (int it = F.vcu; it < M / 64; it += F.G) {
        const int t0 = it * 64 + sub * 16; const size_t o0 = (size_t)t0 * DM + cg8 * 8;
        float p2[8], p1[8];
        if ((t0 & (SEQ - 1)) == 0) {
#pragma unroll
            for (int j = 0; j < 8; ++j) { p2[j] = 0.f; p1[j] = 0.f; }
        } else {
            const u32x4 va = *(const u32x4*)(CVv + o0 - 2 * DM), ca = *(const u32x4*)(CVc + o0 - 2 * DM), vb = *(const u32x4*)(CVv + o0 - DM), cb = *(const u32x4*)(CVc + o0 - DM);
#pragma unroll
            for (int j = 0; j < 4; ++j) { p2[2 * j] = bf_lo(va[j]) * bf_lo(ca[j]); p2[2 * j + 1] = bf_hi(va[j]) * bf_hi(ca[j]); p1[2 * j] = bf_lo(vb[j]) * bf_lo(cb[j]); p1[2 * j + 1] = bf_hi(vb[j]) * bf_hi(cb[j]); }
        }
#pragma unroll 4
        for (int t = 0; t < 16; ++t) {
            const size_t o = o0 + (size_t)t * DM;
            const u32x4 vv = *(const u32x4*)(CVv + o), cc = *(const u32x4*)(CVc + o), bb = *(const u32x4*)(CVb + o), zz = *(const u32x4*)(CVz + o);
            float y[8];
#pragma unroll
            for (int j = 0; j < 4; ++j) {
                const float c0 = bf_lo(vv[j]) * bf_lo(cc[j]), c1 = bf_hi(vv[j]) * bf_hi(cc[j]);
                const float z0 = bf_lo(zz[j]), z1 = bf_hi(zz[j]);
                y[2 * j] = bf_lo(bb[j]) * (w0[2 * j] * p2[2 * j] + w1[2 * j] * p1[2 * j] + w2[2 * j] * c0) * (z0 * fast_sigmoid(z0));
                y[2 * j + 1] = bf_hi(bb[j]) * (w0[2 * j + 1] * p2[2 * j + 1] + w1[2 * j + 1] * p1[2 * j + 1] + w2[2 * j + 1] * c1) * (z1 * fast_sigmoid(z1));
                p2[2 * j] = p1[2 * j]; p2[2 * j + 1] = p1[2 * j + 1]; p1[2 * j] = c0; p1[2 * j + 1] = c1;
            }
            u32x4 w; w.x = cvt_pk_bf16(y[0], y[1]); w.y = cvt_pk_bf16(y[2], y[3]); w.z = cvt_pk_bf16(y[4], y[5]); w.w = cvt_pk_bf16(y[6], y[7]);
            *(u32x4*)(YC + o) = w;
        }
    }
}

constexpr int KV_STRIDE = 160, KV_ROWS = 384, KV_IMG = KV_ROWS * KV_STRIDE;
__device__ __forceinline__ void attn_issue(const bf16_t* Qg, const bf16_t* SZ, const float* sinks, long qrow0, int hk, int it, int fq, bf16x8 (&q)[2], u32x2 (&sz)[4], float& sk) {
    const int rg = it >> 2, h = hk * 4 + (it & 3);
    const size_t ro = (size_t)(qrow0 + 128 * rg) * DM + h * HD;
    q[0] = *(const bf16x8*)(Qg + ro + 8 * fq); q[1] = *(const bf16x8*)(Qg + ro + 32 + 8 * fq);
#pragma unroll
    for (int dt = 0; dt < 4; ++dt) sz[dt] = *(const u32x2*)(SZ + ro + 16 * dt + 4 * fq);
    sk = sinks[h];
}
__device__ __forceinline__ void attn_phase(Frame& F, int l) {
    const bf16_t* Qg = (const bf16_t*)(F.ws + WS_Q); const bf16_t* Kg = (const bf16_t*)(F.ws + WS_K); const bf16_t* Vg = (const bf16_t*)(F.ws + WS_V);
    const bf16_t* SZ = (const bf16_t*)(F.ws + WS_SZ); bf16_t* OA = (bf16_t*)(F.ws + WS_OA);
    const float* sinks = F.sinks + l * NQH;
    LAS unsigned char* Kl = F.lds; LAS unsigned char* Vl = F.lds + KV_IMG;
    const int lane = F.lane, w = F.wave, fr = lane & 15, fq = lane >> 4;
    constexpr int NDU = BATCH * NKVH * (SEQ / 256);
    const float NEG = -INFINITY;
    for (int du = F.vcu; du < NDU; du += F.G) {
        const int n2 = du & 15, hk = (du >> 4) & 3, b = du >> 6;
        const long seq0 = (long)b * SEQ; const int band0 = 256 * n2 - 128;
        u32x4 kreg[6], vreg[6];
#pragma unroll
        for (int i = 0; i < 6; ++i) {
            const int idx = F.tid + 512 * i, r = idx >> 3, ch = idx & 7; int t = band0 + r; t = t < 0 ? 0 : t;
            const size_t go = (size_t)(seq0 + t) * KVW + hk * HD + ch * 8; kreg[i] = *(const u32x4*)(Kg + go); vreg[i] = *(const u32x4*)(Vg + go);
        }
        const long qrow0 = seq0 + 256 * n2 + 16 * w + fr;
        bf16x8 qc[2], qn[2]; u32x2 szc[4], szn[4]; float skc, skn;
        attn_issue(Qg, SZ, sinks, qrow0, hk, 0, fq, qn, szn, skn);
#pragma unroll
        for (int i = 0; i < 6; ++i) {
            const int idx = F.tid + 512 * i, r = idx >> 3, ch = idx & 7;
            *(LAS u32x4*)(Kl + r * KV_STRIDE + ch * 16) = kreg[i]; *(LAS u32x4*)(Vl + r * KV_STRIDE + ch * 16) = vreg[i];
        }
        __syncthreads();
        const int t9 = (w + 9 > 15 ? 15 : w + 9) - w;
#pragma unroll 1
        for (int it = 0; it < 8; ++it) {
            const int rg = it >> 2, h = hk * 4 + (it & 3);
            qc[0] = qn[0]; qc[1] = qn[1]; skc = skn;
#pragma unroll
            for (int dt = 0; dt < 4; ++dt) szc[dt] = szn[dt];
            attn_issue(Qg, SZ, sinks, qrow0, hk, it < 7 ? it + 1 : 7, fq, qn, szn, skn);
            const LAS unsigned char* kbase = Kl + (128 * rg + 16 * w + fr) * KV_STRIDE + 16 * fq;
            const LAS unsigned char* vbase = Vl + (128 * rg + 16 * w + 4 * fq + (fr >> 2)) * KV_STRIDE + 8 * (fr & 3);
            const float sink2 = skc * LOG2E;
            f32x4 st[9];
#pragma unroll
            for (int j = 0; j < 9; ++j) {
                const bf16x8 k0 = *(const LAS bf16x8*)(kbase + j * 16 * KV_STRIDE), k1 = *(const LAS bf16x8*)(kbase + j * 16 * KV_STRIDE + 64);
                f32x4 a = __builtin_amdgcn_mfma_f32_16x16x32_bf16(k0, qc[0], (f32x4){0.f, 0.f, 0.f, 0.f}, 0, 0, 0);
                st[j] = __builtin_amdgcn_mfma_f32_16x16x32_bf16(k1, qc[1], a, 0, 0, 0);
            }
#pragma unroll
            for (int i = 0; i < 4; ++i) { const int kk = 4 * fq + i; if (!(kk > fr)) st[0][i] = NEG; if (kk > fr) st[8][i] = NEG; }
            if (n2 == 0 && rg == 0) {
#pragma unroll
                for (int j = 0; j < 8; ++j) if (w + j < 8) st[j] = (f32x4){NEG, NEG, NEG, NEG};
            }
            float mx = sink2;
#pragma unroll
            for (int j = 0; j < 9; ++j) mx = fmaxf(mx, fmaxf(fmaxf(st[j][0], st[j][1]), fmaxf(st[j][2], st[j][3])));
            mx = fmaxf(mx, __shfl_xor(mx, 16)); mx = fmaxf(mx, __shfl_xor(mx, 32));
            float sum = 0.f;
#pragma unroll
            for (int j = 0; j < 9; ++j)
#pragma unroll
                for (int i = 0; i < 4; ++i) { st[j][i] = __builtin_amdgcn_exp2f(st[j][i] - mx); sum += st[j][i]; }
            sum += __shfl_xor(sum, 16); sum += __shfl_xor(sum, 32);
            const float inv = __builtin_amdgcn_rcpf(sum + __builtin_amdgcn_exp2f(sink2 - mx));
            f32x4 ot[4];
#pragma unroll
            for (int dt = 0; dt < 4; ++dt) ot[dt] = (f32x4){0.f, 0.f, 0.f, 0.f};
#pragma unroll
            for (int s5 = 0; s5 < 5; ++s5) {
                u32x4 pw;
                pw.x = cvt_pk_bf16(st[2 * s5][0], st[2 * s5][1]); pw.y = cvt_pk_bf16(st[2 * s5][2], st[2 * s5][3]);
                if (s5 < 4) { pw.z = cvt_pk_bf16(st[2 * s5 + 1][0], st[2 * s5 + 1][1]); pw.w = cvt_pk_bf16(st[2 * s5 + 1][2], st[2 * s5 + 1][3]); } else { pw.z = 0u; pw.w = 0u; }
                const bf16x8 pf = __builtin_bit_cast(bf16x8, pw);
                const int off0 = (2 * s5) * 16 * KV_STRIDE, off1 = (s5 < 4 ? (2 * s5 + 1) : t9) * 16 * KV_STRIDE;
#pragma unroll
                for (int dt = 0; dt < 4; ++dt) {
                    const s16x4 lo = __builtin_bit_cast(s16x4, __builtin_amdgcn_ds_read_tr16_b64_v4i16((LAS s16x4*)(vbase + off0 + 32 * dt)));
                    const s16x4 hi = __builtin_bit_cast(s16x4, __builtin_amdgcn_ds_read_tr16_b64_v4i16((LAS s16x4*)(vbase + off1 + 32 * dt)));
                    const bf16x8 vf = (bf16x8){lo[0], lo[1], lo[2], lo[3], hi[0], hi[1], hi[2], hi[3]};
                    ot[dt] = __builtin_amdgcn_mfma_f32_16x16x32_bf16(vf, pf, ot[dt], 0, 0, 0);
                }
            }
            bf16_t* op = OA + (size_t)(qrow0 + 128 * rg) * DM + h * HD + 4 * fq;
#pragma unroll
            for (int dt = 0; dt < 4; ++dt) {
                u32x2 o; o.x = cvt_pk_bf16(ot[dt][0] * inv * bf_lo(szc[dt].x), ot[dt][1] * inv * bf_hi(szc[dt].x)); o.y = cvt_pk_bf16(ot[dt][2] * inv * bf_lo(szc[dt].y), ot[dt][3] * inv * bf_hi(szc[dt].y));
                *(u32x2*)(op + 16 * dt) = o;
            }
        }
        __syncthreads();
    }
}

#define XB_TMO      128
#define XB_XCNT(j)  (256  + 64 * (j))
#define XB_XSUB(j)  (1280 + 64 * (j))
#define XB_XGEN(j)  (2304 + 64 * (j))
#define XB_TOP      3328
#define XB_TOPGEN   3392
#define XCD_BAR_WORDS 3456
#define XB_SPIN_CAP (1u << 18)
__device__ __forceinline__ unsigned xb_ld(unsigned* p)              { return __hip_atomic_load(p, __ATOMIC_RELAXED, __HIP_MEMORY_SCOPE_AGENT); }
__device__ __forceinline__ unsigned xb_add(unsigned* p, unsigned v) { return __hip_atomic_fetch_add(p, v, __ATOMIC_RELAXED, __HIP_MEMORY_SCOPE_AGENT); }
__device__ __forceinline__ unsigned xb_xcc_id() { return (unsigned)__builtin_amdgcn_s_getreg((3 << 11) | 20) & 0xFu; }
#define XB_SPIN(cond, bar) do { unsigned _sp = 0; while (cond) { __builtin_amdgcn_s_sleep(1); \
    if ((++_sp & 255u) == 0u) { if (xb_ld(&(bar)[XB_TMO])) break; if (_sp > XB_SPIN_CAP) { atomicAdd(&(bar)[XB_TMO], 1u); break; } } } } while (0)
struct XcdBarrier { unsigned* bar; unsigned x; volatile LAS unsigned* st; };
__device__ __forceinline__ XcdBarrier xcd_barrier_post(unsigned* bar, volatile LAS unsigned* st) {
    XcdBarrier b; b.bar = bar; b.x = xb_xcc_id(); b.st = st;
    if (threadIdx.x == 0) (void)xb_add(&bar[XB_XCNT(b.x)], 1u);
    return b;
}
__device__ __forceinline__ void xcd_barrier_complete(unsigned* bar, unsigned x, unsigned& nloc, unsigned& nx) {
    const unsigned G = gridDim.x * gridDim.y * gridDim.z;
    unsigned sum, cnt, mine, sp = 0u;
    for (;;) {
        sum = 0u; cnt = 0u; mine = 0u;
#pragma unroll
        for (unsigned j = 0; j < 16; ++j) { const unsigned c = xb_ld(&bar[XB_XCNT(j)]); sum += c; cnt += (c > 0u) ? 1u : 0u; mine = (j == x) ? c : mine; }
        if (sum == G) break;
        __builtin_amdgcn_s_sleep(1);
        if ((++sp & 255u) == 0u) { if (xb_ld(&bar[XB_TMO])) break; if (sp > XB_SPIN_CAP) { atomicAdd(&bar[XB_TMO], 1u); break; } }
    }
    nloc = mine > 0u ? mine : 1u; nx = cnt > 0u ? cnt : 1u;
}
__device__ __forceinline__ void xcd_barrier(const XcdBarrier& b) {
    asm volatile("s_waitcnt vmcnt(0)" ::: "memory");
    __syncthreads();
    if (threadIdx.x == 0) {
        unsigned* bar = b.bar;
        __builtin_amdgcn_s_waitcnt(0);
        unsigned nloc = b.st[0], nx = b.st[1];
        if (nloc == 0u) { xcd_barrier_complete(bar, b.x, nloc, nx); b.st[0] = nloc; b.st[1] = nx; }
        const unsigned old = xb_add(&bar[XB_XSUB(b.x)], 1u);
        const unsigned gen = old / nloc;
        if (old + 1u == (gen + 1u) * nloc) {
            __builtin_amdgcn_fence(__ATOMIC_RELEASE, "agent");
            asm volatile("s_waitcnt vmcnt(0)" ::: "memory");
            const unsigned og = xb_add(&bar[XB_TOP], 1u);
            const unsigned tg = og / nx;
            if (og + 1u == (tg + 1u) * nx) xb_add(&bar[XB_TOPGEN], 1u);
            else XB_SPIN(xb_ld(&bar[XB_TOPGEN]) == tg, bar);
            __builtin_amdgcn_fence(__ATOMIC_ACQUIRE, "agent");
            xb_add(&bar[XB_XGEN(b.x)], 1u);
            asm volatile("s_waitcnt vmcnt(0)" ::: "memory");
        } else {
            XB_SPIN(xb_ld(&bar[XB_XGEN(b.x)]) == gen, bar);
            __builtin_amdgcn_fence(__ATOMIC_ACQUIRE, "agent");
            asm volatile("s_waitcnt vmcnt(0)" ::: "memory");
        }
    }
    __syncthreads();
}

struct Args { const float* in[11]; float* out; unsigned char* ws; int ph_lo, ph_hi; };
constexpr int NPHASES = 1 + 4 * DEPTH;

__global__ void __launch_bounds__(NWAVES * 64, 2) fwd_kernel(Args args) {
    extern __shared__ __attribute__((aligned(16))) unsigned char lds_raw[];
    const int lo = args.ph_lo, hi = args.ph_hi;
    volatile LAS unsigned* MISC = (volatile LAS unsigned*)((LAS unsigned char*)lds_raw + 131072 + 320);
    if (threadIdx.x < 32) MISC[threadIdx.x] = 0u;
    __syncthreads();
    XcdBarrier bar = xcd_barrier_post((unsigned*)(args.ws + WS_CTL), MISC + 8);
    for (int ph = lo; ph < hi; ++ph) {
        if (ph > lo) { if (ph == 1) cg::this_grid().sync(); else xcd_barrier(bar); }
        Frame F;
        F.lds = (LAS unsigned char*)lds_raw;
        { int t = threadIdx.x; asm volatile("" : "+v"(t)); F.tid = t; }
        F.lane = F.tid & 63; F.wave = __builtin_amdgcn_readfirstlane(F.tid >> 6);
        { int gsz = gridDim.x, bx = blockIdx.x; asm volatile("" : "+s"(gsz), "+s"(bx)); F.G = gsz; F.bx = bx; F.vcu = (F.G % 8 == 0) ? (bx % 8) * (F.G / 8) + bx / 8 : bx; }
        F.x = args.in[0]; F.norm_g = args.in[1]; F.w_in = args.in[2]; F.conv_w = args.in[3]; F.qng = args.in[4]; F.kng = args.in[5]; F.sinks = args.in[6];
        F.w_co = args.in[7]; F.w_ao = args.in[8]; F.gate_b = args.in[9]; F.w_out = args.in[10]; F.out = args.out;
        size_t wz = 0; asm volatile("" : "+s"(wz)); unsigned char* ws = args.ws + wz; F.ws = ws;
        float* rowss = (float*)(ws + WS_ROWSS);
        bf16_t* XB = (bf16_t*)(ws + WS_XB);
        if (ph == 0) { p0_prologue(F); if (PROBE_DUP & 1) p0_prologue(F); continue; }
        const int l = (ph - 1) >> 2, s = (ph - 1) & 3;
        unsigned char* wl = ws + WS_W + (size_t)l * W_LAYER;
        if (s == 0) {
            pg8::Gemm g{XB, (const bf16_t*)wl, XB, (const bf16_t*)wl, DM};
            pg8::StaticOrder S; S.init(M, NCOLS, F.G, F.bx, 1);
            EpiIn E{(bf16_t*)(ws + WS_CV), (bf16_t*)(ws + WS_Q), (bf16_t*)(ws + WS_K), (bf16_t*)(ws + WS_V), (bf16_t*)(ws + WS_SZ), (bf16_t*)(ws + WS_G),
                    rowss + (size_t)l * M, F.qng + l * HD, F.kng + l * HD, F.gate_b + l * 2 * DM};
            pg8::gemm_phase<EpiIn, true, true>(F.lds, F.tid, g, S, E);
            if (PROBE_DUP & 2) pg8::gemm_phase<EpiIn, true, true>(F.lds, F.tid, g, S, E);
        } else if (s == 1) {
            attn_phase(F, l); if (PROBE_DUP & 4) attn_phase(F, l);
            conv_phase(F, l); if (PROBE_DUP & 8) conv_phase(F, l);
        } else if (s == 2) {
            pg8::Gemm g{(const bf16_t*)(ws + WS_YC), (const bf16_t*)(wl + W_CO), (const bf16_t*)(ws + WS_OA), (const bf16_t*)(wl + W_AO), DM};
            pg8::StaticOrder S; S.init(M, DM, F.G, F.bx, 2);
            EpiMerge E{(const bf16_t*)(ws + WS_G), (bf16_t*)(ws + WS_MG)};
            pg8::gemm_phase<EpiMerge, true, true>(F.lds, F.tid, g, S, E);
            if (PROBE_DUP & 16) pg8::gemm_phase<EpiMerge, true, true>(F.lds, F.tid, g, S, E);
        } else {
            pg8::Gemm g{(const bf16_t*)(ws + WS_MG), (const bf16_t*)(wl + W_OUT), (const bf16_t*)(ws + WS_MG), (const bf16_t*)(wl + W_OUT), DM};
            pg8::StaticOrder S; S.init(M, DM, F.G, F.bx, 1);
            const bool lastl = (l == DEPTH - 1);
            EpiOut E{l == 0 ? F.x : F.out, F.out, XB, lastl ? nullptr : rowss + (size_t)(l + 1) * M};
            if (PROBE_DUP & 32) { EpiOut E2{l == 0 ? F.x : F.out, (float*)(ws + WS_CV), XB, nullptr}; pg8::gemm_phase<EpiOut, true, true>(F.lds, F.tid, g, S, E2); }
            pg8::gemm_phase<EpiOut, true, true>(F.lds, F.tid, g, S, E);
        }
    }
}

extern "C" void kernel_launch(void* const* d_in, const int* in_sizes, int n_in, void* d_out, int out_size, void* d_ws, size_t ws_size, hipStream_t stream) {
    static int grid = 0;
    if (grid == 0) {
        if (n_in != 11 || in_sizes[0] != M * DM || out_size != M * DM || ws_size < WS_END) {
            fprintf(stderr, "kernel_launch: unexpected shapes: n_in %d in0 %d out %d ws %zu (need %zu)\n", n_in, n_in > 0 ? in_sizes[0] : -1, out_size, ws_size, (size_t)WS_END); grid = -1; return; }
        int dev = 0, cus = 0, per_cu = 0;
        hipGetDevice(&dev); hipDeviceGetAttribute(&cus, hipDeviceAttributeMultiprocessorCount, dev);
        if (hipFuncSetAttribute((const void*)fwd_kernel, hipFuncAttributeMaxDynamicSharedMemorySize, LDS_BYTES) != hipSuccess) { fprintf(stderr, "kernel_launch: hipFuncSetAttribute failed\n"); grid = -1; return; }
        if (hipOccupancyMaxActiveBlocksPerMultiprocessor(&per_cu, (const void*)fwd_kernel, NWAVES * 64, LDS_BYTES) != hipSuccess || per_cu < 1) { fprintf(stderr, "kernel_launch: occupancy query says %d\n", per_cu); per_cu = 1; }
        (void)hipGetLastError();
        grid = cus * 1;
        fprintf(stderr, "kernel_launch: grid %d (cus %d, per_cu %d)\n", grid, cus, per_cu);
    }
    if (grid < 0) return;
    Args a{};
    for (int i = 0; i < 11; ++i) a.in[i] = (const float*)d_in[i];
    a.out = (float*)d_out; a.ws = (unsigned char*)d_ws;
    if (hipMemsetAsync((char*)d_ws + WS_CTL, 0, CTL_BYTES, stream) != hipSuccess) { fprintf(stderr, "kernel_launch: memset failed\n"); return; }
#if MK_ONE_LAUNCH
    a.ph_lo = 0; a.ph_hi = NPHASES;
    void* kargs[] = {&a};
    hipError_t e = hipLaunchCooperativeKernel((const void*)fwd_kernel, dim3(grid), dim3(NWAVES * 64), kargs, LDS_BYTES, stream);
    if (e != hipSuccess) fprintf(stderr, "kernel_launch: cooperative launch failed: %s (grid %d)\n", hipGetErrorString(e), grid);
#else
    for (int p = 0; p < NPHASES; ++p) { a.ph_lo = p; a.ph_hi = p + 1; hipLaunchKernelGGL(fwd_kernel, dim3(grid), dim3(NWAVES * 64), LDS_BYTES, stream, a); }
#endif
}
```

```cpp
#include <hip/hip_runtime.h>
#include <hip/hip_cooperative_groups.h>
#include <cstdio>
#include <cstdint>
namespace cg = cooperative_groups;

#ifndef PROBE_DUP
#define PROBE_DUP 0
#endif
#ifndef MK_ONE_LAUNCH
#define MK_ONE_LAUNCH 1
#endif

#define LAS __attribute__((address_space(3)))
typedef unsigned short bf16_t;
typedef short bf16x8 __attribute__((ext_vector_type(8)));
typedef short s16x4 __attribute__((ext_vector_type(4)));
typedef float f32x4 __attribute__((ext_vector_type(4)));
typedef unsigned u32x4 __attribute__((ext_vector_type(4)));
typedef unsigned u32x2 __attribute__((ext_vector_type(2)));

constexpr int DM = 1024, BATCH = 4, SEQ = 4096, DEPTH = 4, M = BATCH * SEQ;
constexpr int NQH = 16, NKVH = 4, HD = 64, KVW = NKVH * HD;
constexpr int NCOLS = 4 * DM + DM + 2 * KVW + DM + 2 * DM;
constexpr float EPS = 1e-6f;
constexpr float LOG2E = 1.4426950408889634f;
constexpr float QSCALE = 0.125f * LOG2E;

constexpr size_t MiB = 1u << 20;
constexpr size_t WS_ROWSS = 0;
constexpr size_t WS_CTL = 512 * 1024, CTL_BYTES = 16384;
constexpr size_t WS_W = 1 * MiB;
constexpr size_t W_LAYER = 23 * MiB, W_CO = 17 * MiB, W_AO = 19 * MiB, W_OUT = 21 * MiB;
constexpr size_t WS_XB = 96 * MiB;
constexpr size_t WS_CV = 128 * MiB;
constexpr size_t WS_Q = 256 * MiB;
constexpr size_t WS_K = 288 * MiB;
constexpr size_t WS_V = 296 * MiB;
constexpr size_t WS_SZ = 304 * MiB;
constexpr size_t WS_G = 336 * MiB;
constexpr size_t WS_YC = 400 * MiB;
constexpr size_t WS_OA = 432 * MiB;
constexpr size_t WS_MG = 464 * MiB;
constexpr size_t WS_END = 496 * MiB;

constexpr int NWAVES = 8;
constexpr int LDS_BYTES = 147456;

typedef float f32x2_t __attribute__((ext_vector_type(2))); typedef __bf16 bf16x2_t __attribute__((ext_vector_type(2)));
__device__ __forceinline__ unsigned cvt_pk_bf16(float lo, float hi) { f32x2_t v = {lo, hi}; bf16x2_t b = __builtin_convertvector(v, bf16x2_t); return __builtin_bit_cast(unsigned, b); }
__device__ __forceinline__ float bf_lo(unsigned u) { return __uint_as_float(u << 16); }
__device__ __forceinline__ float bf_hi(unsigned u) { return __uint_as_float(u & 0xffff0000u); }
__device__ __forceinline__ float fast_sigmoid(float v) { return __builtin_amdgcn_rcpf(1.0f + __builtin_amdgcn_exp2f(-v * LOG2E)); }

namespace pg8 {
constexpr int BM = 256, BK = 64, HALF = 128, HTB = HALF * BK * 2, STAGE_BYTES = 8 * HTB, NXCD = 8, WGM = 8;
__host__ __device__ __forceinline__ int lds_byte(int r, int c) { const int st = (r >> 4) * 2 + (c >> 5), rr = r & 15, cc = c & 31, ob = rr * 64 + cc * 2; return st * 1024 + (ob ^ (((ob >> 9) & 1) << 5)); }
__host__ __device__ __forceinline__ void stage_rc(int b, int& R, int& C) { const int st = b / 1024, sb = b % 1024, swz = sb ^ (((sb >> 9) & 1) << 5); R = (st >> 1) * 16 + swz / 64; C = (st & 1) * 32 + (swz % 64) / 2; }
__host__ __device__ __forceinline__ int perm32(int rho) { const int n = rho >> 4, i = rho & 15; return 8 * (i >> 2) + 4 * n + (i & 3); }

struct Unit { int pm, pn, seg; };
struct Gemm { const bf16_t* A0; const bf16_t* B0; const bf16_t* A1; const bf16_t* B1; int K; };

struct StaticOrder {
    int nM, nN, nwg, G, c, nseg;
    __device__ void init(int M_, int N_, int G_, int c_, int nseg_) { nM = M_ / BM; nN = N_ / BM; nwg = nM * nN; G = G_; c = c_; nseg = nseg_; }
    __device__ bool next(int i, Unit& u) const {
        int ti = i; u.seg = 0;
        if (nseg == 2) { ti = i >> 1; u.seg = i & 1; }
        const long L = (long)ti * G + c; if (L >= nwg) return false;
        int wgid = (int)L; { const int q = nwg / NXCD, r = nwg % NXCD, xcd = wgid % NXCD, off = wgid / NXCD; wgid = (xcd < r ? xcd * (q + 1) : r * (q + 1) + (xcd - r) * q) + off; }
        const int nig = WGM * nN, gid = wgid / nig, fm = gid * WGM, gsz = (nM - fm) < WGM ? (nM - fm) : WGM;
        u.pm = fm + ((wgid % nig) % gsz); u.pn = (wgid % nig) / gsz; return true;
    }
};

typedef f32x4 Acc[2][2][4][2];

template <class Epi, bool ALIGN_EPI, bool SP2>
__device__ __forceinline__ void gemm_phase(LAS unsigned char* lds, const int tid, const Gemm g, const StaticOrder& S, const Epi& E) {
    const int wid = __builtin_amdgcn_readfirstlane(tid >> 6), lane = tid & 63, wr = wid >> 2, wc = wid & 3, fr = lane & 15, fq = lane >> 4;
    const int K = g.K, nt = K / BK;
    unsigned voffA[2], voffB[2];
#pragma unroll
    for (int i = 0; i < 2; ++i) { int R, C; stage_rc(tid * 16 + i * 8192, R, C); const int Rb = Epi::PERM ? ((R & ~31) + perm32(R & 31)) : R;
        voffA[i] = (unsigned)(R * K + C) * 2u; voffB[i] = (unsigned)(Rb * K + C) * 2u; }
    const size_t kstep = (size_t)(BK * 2);
    const size_t hstep = (size_t)HALF * K * 2;
    const size_t tstep = 2 * hstep;
    const unsigned ldsw = (unsigned)wid * 1024u;
    const int aoff = lds_byte(wr * 64 + fr, fq * 8), boff = lds_byte(wc * 32 + fr, fq * 8);
#define PG8_SA(b, h) (((b) * 2 + (h)) * HTB)
#define PG8_SB(b, h) ((4 + (b) * 2 + (h)) * HTB)
#define PG8_STAGE(bufoff, gbase, voff) do { _Pragma("unroll") for (int _i = 0; _i < 2; ++_i) \
        __builtin_amdgcn_global_load_lds((const unsigned*)((const char*)(gbase) + (voff)[_i]), (LAS unsigned*)(lds + (bufoff) + ldsw + _i * 8192), 16, 0, 0); } while (0)
#define PG8_LDA(dst, b, h) do { _Pragma("unroll") for (int m = 0; m < 4; ++m) _Pragma("unroll") for (int k = 0; k < 2; ++k) dst[m][k] = *(const LAS bf16x8*)(lds + PG8_SA(b, h) + aoff + m * 2048 + k * 1024); } while (0)
#define PG8_LDB(dst, b, h) do { _Pragma("unroll") for (int n = 0; n < 2; ++n) _Pragma("unroll") for (int k = 0; k < 2; ++k) dst[n][k] = *(const LAS bf16x8*)(lds + PG8_SB(b, h) + boff + n * 2048 + k * 1024); } while (0)
#define PG8_MMA(ai, bj, At, Bt) do { __builtin_amdgcn_s_setprio(1); _Pragma("unroll") for (int m = 0; m < 4; ++m) _Pragma("unroll") for (int n = 0; n < 2; ++n) _Pragma("unroll") for (int k = 0; k < 2; ++k) \
        acc[ai][bj][m][n] = __builtin_amdgcn_mfma_f32_16x16x32_bf16(Bt[n][k], At[m][k], acc[ai][bj][m][n], 0, 0, 0); __builtin_amdgcn_s_setprio(0); } while (0)
#define PG8_WAIT_V(n) asm volatile("s_waitcnt vmcnt(" #n ")" ::: "memory")
#define PG8_WAIT_L(n) asm volatile("s_waitcnt lgkmcnt(" #n ")" ::: "memory")
#define PG8_BAR __builtin_amdgcn_s_barrier()
#define PG8_SCHED __builtin_amdgcn_sched_barrier(0)
    Unit cur, nxt; int ui = 0;
    if (!S.next(0, cur)) return;
    Acc acc;
#pragma unroll
    for (int a = 0; a < 2; ++a)
#pragma unroll
        for (int b = 0; b < 2; ++b)
#pragma unroll
            for (int m = 0; m < 4; ++m)
#pragma unroll
                for (int n = 0; n < 2; ++n) acc[a][b][m][n] = (f32x4){0.f, 0.f, 0.f, 0.f};
    bf16x8 At[4][2], B0[2][2], B1[2][2];
    const char* cA = (const char*)(cur.seg ? g.A1 : g.A0) + (size_t)cur.pm * tstep; const char* cB = (const char*)(cur.seg ? g.B1 : g.B0) + (size_t)cur.pn * tstep;
    if constexpr (SP2) {
        PG8_STAGE(PG8_SB(0, 0), cB, voffB); PG8_STAGE(PG8_SB(0, 1), cB + hstep, voffB); PG8_STAGE(PG8_SA(0, 0), cA, voffA); PG8_STAGE(PG8_SA(0, 1), cA + hstep, voffA);
        if (wr == 1) PG8_BAR;
        PG8_WAIT_V(2); PG8_BAR;
        PG8_STAGE(PG8_SB(1, 0), cB + kstep, voffB); PG8_STAGE(PG8_SA(1, 0), cA + kstep, voffA); PG8_STAGE(PG8_SB(1, 1), cB + hstep + kstep, voffB);
        PG8_WAIT_V(6); PG8_BAR;
    } else {
        PG8_STAGE(PG8_SB(0, 0), cB, voffB); PG8_STAGE(PG8_SA(0, 0), cA, voffA); PG8_STAGE(PG8_SB(0, 1), cB + hstep, voffB); PG8_STAGE(PG8_SA(0, 1), cA + hstep, voffA);
        if (wr == 1) PG8_BAR;
        PG8_WAIT_V(4); PG8_BAR;
        PG8_STAGE(PG8_SB(1, 0), cB + kstep, voffB); PG8_STAGE(PG8_SA(1, 0), cA + kstep, voffA); PG8_STAGE(PG8_SB(1, 1), cB + hstep + kstep, voffB);
        PG8_WAIT_V(6); PG8_BAR;
    }
    for (;;) {
        const bool has_next = S.next(ui + 1, nxt);
        const char* nA = has_next ? (const char*)(nxt.seg ? g.A1 : g.A0) + (size_t)nxt.pm * tstep : cA; const char* nB = has_next ? (const char*)(nxt.seg ? g.B1 : g.B0) + (size_t)nxt.pn * tstep : cB;
        for (int t = 0; t < nt; t += 2) {
            const bool last = (t == nt - 2);
            const char* a1 = cA + (size_t)(t + 1) * kstep;
            const char* a2 = last ? nA : cA + (size_t)(t + 2) * kstep; const char* b2 = last ? nB : cB + (size_t)(t + 2) * kstep;
            const char* a3 = a2 + kstep; const char* b3 = b2 + kstep;
            if constexpr (SP2) {
            PG8_LDB(B0, 0, 0); PG8_LDB(B1, 0, 1); PG8_SCHED; PG8_LDA(At, 0, 0); PG8_STAGE(PG8_SA(1, 1), a1 + hstep, voffA);
            PG8_WAIT_V(8); PG8_WAIT_L(0); PG8_BAR; PG8_MMA(0, 0, At, B0); PG8_MMA(0, 1, At, B1); PG8_BAR; PG8_SCHED;
            PG8_LDA(At, 0, 1); PG8_STAGE(PG8_SB(0, 0), b2, voffB); PG8_STAGE(PG8_SB(0, 1), b2 + hstep, voffB); PG8_STAGE(PG8_SA(0, 0), a2, voffA);
            PG8_WAIT_V(8); PG8_WAIT_L(0); PG8_BAR; PG8_MMA(1, 0, At, B0); PG8_MMA(1, 1, At, B1); PG8_BAR; PG8_SCHED;
            PG8_LDB(B0, 1, 0); PG8_LDB(B1, 1, 1); PG8_SCHED; PG8_LDA(At, 1, 0); PG8_STAGE(PG8_SA(0, 1), a2 + hstep, voffA);
            PG8_WAIT_V(8); PG8_WAIT_L(0); PG8_BAR; PG8_MMA(0, 0, At, B0); PG8_MMA(0, 1, At, B1); PG8_BAR; PG8_SCHED;
            PG8_LDA(At, 1, 1); PG8_STAGE(PG8_SB(1, 0), b3, voffB); PG8_STAGE(PG8_SB(1, 1), b3 + hstep, voffB); PG8_STAGE(PG8_SA(1, 0), a3, voffA);
            PG8_WAIT_V(8); PG8_WAIT_L(0); PG8_BAR; PG8_MMA(1, 0, At, B0); PG8_MMA(1, 1, At, B1); PG8_BAR; PG8_SCHED;
            } else {
            PG8_LDB(B0, 0, 0); PG8_SCHED; PG8_LDA(At, 0, 0); PG8_STAGE(PG8_SA(1, 1), a1 + hstep, voffA);
            PG8_WAIT_L(8); PG8_BAR; PG8_WAIT_L(0); PG8_MMA(0, 0, At, B0); PG8_BAR; PG8_SCHED;
            PG8_LDB(B1, 0, 1); PG8_STAGE(PG8_SB(0, 0), b2, voffB);
            PG8_BAR; PG8_WAIT_L(0); PG8_MMA(0, 1, At, B1); PG8_BAR;
            PG8_LDA(At, 0, 1); PG8_STAGE(PG8_SA(0, 0), a2, voffA);
            PG8_BAR; PG8_WAIT_L(0); PG8_MMA(1, 0, At, B0); PG8_BAR; PG8_SCHED;
            PG8_STAGE(PG8_SB(0, 1), b2 + hstep, voffB);
            PG8_WAIT_V(6); PG8_BAR; PG8_MMA(1, 1, At, B1); PG8_BAR;
            PG8_LDB(B0, 1, 0); PG8_SCHED; PG8_LDA(At, 1, 0); PG8_STAGE(PG8_SA(0, 1), a2 + hstep, voffA);
            PG8_WAIT_L(8); PG8_BAR; PG8_WAIT_L(0); PG8_MMA(0, 0, At, B0); PG8_BAR; PG8_SCHED;
            PG8_LDB(B1, 1, 1); PG8_STAGE(PG8_SB(1, 0), b3, voffB);
            PG8_BAR; PG8_WAIT_L(0); PG8_MMA(0, 1, At, B1); PG8_BAR;
            PG8_LDA(At, 1, 1); PG8_STAGE(PG8_SA(1, 0), a3, voffA);
            PG8_BAR; PG8_WAIT_L(0); PG8_MMA(1, 0, At, B0); PG8_BAR; PG8_SCHED;
            PG8_STAGE(PG8_SB(1, 1), b3 + hstep, voffB);
            PG8_WAIT_V(6); PG8_BAR; PG8_MMA(1, 1, At, B1); PG8_BAR;
            }
        }
        if constexpr (ALIGN_EPI) { if (wr == 0) PG8_BAR; }
        bool keep = false;
        if constexpr (Epi::TWO_SEG) { if (cur.seg == 0) { E.mid(acc, cur, wr, wc, fr, fq); keep = true; } else E(acc, cur, wr, wc, fr, fq); }
        else E(acc, cur, wr, wc, fr, fq);
        if (!has_next) break;
        if (!keep) {
#pragma unroll
        for (int a = 0; a < 2; ++a)
#pragma unroll
            for (int b = 0; b < 2; ++b)
#pragma unroll
                for (int m = 0; m < 4; ++m)
#pragma unroll
                    for (int n = 0; n < 2; ++n) acc[a][b][m][n] = (f32x4){0.f, 0.f, 0.f, 0.f};
        }
        cur = nxt; cA = nA; cB = nB; ++ui;
        if constexpr (ALIGN_EPI) { if (wr == 1) PG8_BAR; }
    }
    PG8_WAIT_V(0);
    if constexpr (!ALIGN_EPI) { if (wr == 0) PG8_BAR; }
    PG8_BAR;
#undef PG8_SA
#undef PG8_SB
#undef PG8_STAGE
#undef PG8_LDA
#undef PG8_LDB
#undef PG8_MMA
#undef PG8_WAIT_V
#undef PG8_WAIT_L
#undef PG8_BAR
#undef PG8_SCHED
}
}

struct EpiIn {
    static constexpr bool PERM = true, TWO_SEG = false;
    bf16_t *CV, *Q, *Kb, *Vb, *SZ, *G; const float *rowss, *qg, *kg, *gate_b;
    __device__ __forceinline__ void store8(bf16_t* p, const f32x4& v0, const f32x4& v1) const {
        u32x4 w; w.x = cvt_pk_bf16(v0[0], v0[1]); w.y = cvt_pk_bf16(v0[2], v0[3]); w.z = cvt_pk_bf16(v1[0], v1[1]); w.w = cvt_pk_bf16(v1[2], v1[3]); *(u32x4*)p = w; }
    __device__ __forceinline__ void operator()(pg8::Acc& acc, const pg8::Unit& u, int wr, int wc, int fr, int fq) const {
        const int row0 = u.pm * 256 + wr * 64 + fr; const int pn = u.pn;
        float rs[2][4];
#pragma unroll
        for (int ai = 0; ai < 2; ++ai)
#pragma unroll
            for (int m = 0; m < 4; ++m) rs[ai][m] = 1.0f / sqrtf(rowss[row0 + ai * 128 + m * 16] * (1.0f / DM) + EPS);
        if (pn < 16 || pn == 21 || (pn >= 22 && pn < 26)) {
            bf16_t* base; int ld, colt; const bool act = (pn >= 22);
            if (pn < 16) { base = CV + (size_t)(pn >> 2) * ((size_t)M * DM); ld = DM; colt = (pn & 3) * 256; }
            else if (pn == 21) { base = Vb; ld = KVW; colt = 0; }
            else { base = SZ; ld = DM; colt = (pn - 22) * 256; }
            const int col0 = colt + wc * 32 + 8 * fq;
#pragma unroll
            for (int ai = 0; ai < 2; ++ai)
#pragma unroll
                for (int m = 0; m < 4; ++m) { bf16_t* rowp = base + (size_t)(row0 + ai * 128 + m * 16) * ld + col0; const float r = rs[ai][m];
#pragma unroll
                    for (int bj = 0; bj < 2; ++bj) { f32x4 v0 = acc[ai][bj][m][0] * r, v1 = acc[ai][bj][m][1] * r;
                        if (act) {
#pragma unroll
                            for (int i = 0; i < 4; ++i) { v0[i] = v0[i] * fast_sigmoid(v0[i]); v1[i] = v1[i] * fast_sigmoid(v1[i]); } }
                        store8(rowp + bj * 128, v0, v1); } }
        } else if (pn >= 26) {
            const int colt = (pn - 26) * 256, col0 = colt + wc * 32 + 8 * fq;
            f32x4 bv[2][2];
#pragma unroll
            for (int bj = 0; bj < 2; ++bj)
#pragma unroll
                for (int n = 0; n < 2; ++n) bv[bj][n] = *(const f32x4*)(gate_b + col0 + bj * 128 + 4 * n);
#pragma unroll
            for (int ai = 0; ai < 2; ++ai)
#pragma unroll
                for (int m = 0; m < 4; ++m) { bf16_t* rowp = G + (size_t)(row0 + ai * 128 + m * 16) * (2 * DM) + col0; const float r = rs[ai][m];
#pragma unroll
                    for (int bj = 0; bj < 2; ++bj) { f32x4 v0 = acc[ai][bj][m][0] * r + bv[bj][0], v1 = acc[ai][bj][m][1] * r + bv[bj][1];
#pragma unroll
                        for (int i = 0; i < 4; ++i) { v0[i] = fast_sigmoid(v0[i]); v1[i] = fast_sigmoid(v1[i]); }
                        store8(rowp + bj * 128, v0, v1); } }
        } else {
            const bool isq = pn < 20; bf16_t* base = isq ? Q : Kb; const int ld = isq ? DM : KVW, colt = isq ? (pn - 16) * 256 : 0;
            const float* gp = isq ? qg : kg; const float sc = isq ? QSCALE : 1.0f;
            f32x4 gv[2][2];
#pragma unroll
            for (int bj = 0; bj < 2; ++bj)
#pragma unroll
                for (int n = 0; n < 2; ++n) gv[bj][n] = *(const f32x4*)(gp + 32 * bj + 8 * fq + 4 * n) * sc;
            const int col0 = colt + wc * 64 + 8 * fq;
#pragma unroll
            for (int ai = 0; ai < 2; ++ai)
#pragma unroll
                for (int m = 0; m < 4; ++m) { bf16_t* rowp = base + (size_t)(row0 + ai * 128 + m * 16) * ld + col0; const float r = rs[ai][m];
                    f32x4 v[2][2]; float ss = 0.f;
#pragma unroll
                    for (int bj = 0; bj < 2; ++bj)
#pragma unroll
                        for (int n = 0; n < 2; ++n) { v[bj][n] = acc[ai][bj][m][n] * r; ss += (v[bj][n][0] * v[bj][n][0] + v[bj][n][1] * v[bj][n][1]) + (v[bj][n][2] * v[bj][n][2] + v[bj][n][3] * v[bj][n][3]); }
                    ss += __shfl_xor(ss, 16); ss += __shfl_xor(ss, 32);
                    const float rq = 1.0f / sqrtf(ss * (1.0f / HD) + EPS);
#pragma unroll
                    for (int bj = 0; bj < 2; ++bj) store8(rowp + bj * 32, v[bj][0] * rq * gv[bj][0], v[bj][1] * rq * gv[bj][1]); }
        }
    }
};

struct EpiMerge {
    static constexpr bool PERM = true, TWO_SEG = true;
    const bf16_t* G; bf16_t* MG;
    __device__ __forceinline__ void mid(pg8::Acc& acc, const pg8::Unit& u, int wr, int wc, int fr, int fq) const {
        const int row0 = u.pm * 256 + wr * 64 + fr, col0 = u.pn * 256 + wc * 32 + 8 * fq;
#pragma unroll
        for (int ai = 0; ai < 2; ++ai)
#pragma unroll
            for (int m = 0; m < 4; ++m) { const bf16_t* gp = G + (size_t)(row0 + ai * 128 + m * 16) * (2 * DM) + col0;
#pragma unroll
                for (int bj = 0; bj < 2; ++bj) { const u32x4 a = *(const u32x4*)(gp + bj * 128), b = *(const u32x4*)(gp + DM + bj * 128);
#pragma unroll
                    for (int j = 0; j < 4; ++j) { const float r0 = bf_lo(a[j]) * __builtin_amdgcn_rcpf(fmaxf(bf_lo(b[j]), 1e-30f)), r1 = bf_hi(a[j]) * __builtin_amdgcn_rcpf(fmaxf(bf_hi(b[j]), 1e-30f));
                        acc[ai][bj][m][j >> 1][(j & 1) * 2] *= r0; acc[ai][bj][m][j >> 1][(j & 1) * 2 + 1] *= r1; } } }
    }
    __device__ __forceinline__ void operator()(pg8::Acc& acc, const pg8::Unit& u, int wr, int wc, int fr, int fq) const {
        const int row0 = u.pm * 256 + wr * 64 + fr, col0 = u.pn * 256 + wc * 32 + 8 * fq;
#pragma unroll
        for (int ai = 0; ai < 2; ++ai)
#pragma unroll
            for (int m = 0; m < 4; ++m) { const size_t ro = (size_t)(row0 + ai * 128 + m * 16); const bf16_t* gp = G + ro * (2 * DM) + DM + col0; bf16_t* op = MG + ro * DM + col0;
#pragma unroll
                for (int bj = 0; bj < 2; ++bj) { const u32x4 b = *(const u32x4*)(gp + bj * 128); u32x4 w;
#pragma unroll
                    for (int j = 0; j < 4; ++j) w[j] = cvt_pk_bf16(acc[ai][bj][m][j >> 1][(j & 1) * 2] * bf_lo(b[j]), acc[ai][bj][m][j >> 1][(j & 1) * 2 + 1] * bf_hi(b[j]));
                    *(u32x4*)(op + bj * 128) = w; } }
    }
};

struct EpiOut {
    static constexpr bool PERM = false, TWO_SEG = false;
    const float* xin; float* xout; bf16_t* XB; float* rowss_next;
    __device__ __forceinline__ void operator()(pg8::Acc& acc, const pg8::Unit& u, int wr, int wc, int fr, int fq) const {
        const int row0 = u.pm * 256 + wr * 64 + fr, col0 = u.pn * 256 + wc * 32 + 4 * fq;
#pragma unroll
        for (int ai = 0; ai < 2; ++ai)
#pragma unroll
            for (int m = 0; m < 4; ++m) { const size_t off = (size_t)(row0 + ai * 128 + m * 16) * DM + col0; float ss = 0.f;
#pragma unroll
                for (int bj = 0; bj < 2; ++bj)
#pragma unroll
                    for (int n = 0; n < 2; ++n) { const f32x4 xv = *(const f32x4*)(xin + off + bj * 128 + n * 16); const f32x4 o = xv + acc[ai][bj][m][n];
                        *(f32x4*)(xout + off + bj * 128 + n * 16) = o; ss += (o[0] * o[0] + o[1] * o[1]) + (o[2] * o[2] + o[3] * o[3]);
                        if (rowss_next) { u32x2 w; w.x = cvt_pk_bf16(o[0], o[1]); w.y = cvt_pk_bf16(o[2], o[3]); *(u32x2*)(XB + off + bj * 128 + n * 16) = w; } }
                if (rowss_next) { ss += __shfl_xor(ss, 16); ss += __shfl_xor(ss, 32); if (fq == 0) atomicAdd(rowss_next + row0 + ai * 128 + m * 16, ss); } }
    }
};

struct Frame {
    LAS unsigned char* lds; int tid, lane, wave, vcu, G, bx;
    const float *x, *norm_g, *w_in, *conv_w, *qng, *kng, *sinks, *w_co, *w_ao, *gate_b, *w_out; float* out; unsigned char* ws;
};
__device__ __forceinline__ float wave_sum(float v) {
#pragma unroll
    for (int o = 1; o < 64; o <<= 1) v += __shfl_xor(v, o);
    return v;
}
constexpr int P0_SCR = 64 * 65 * 4;
__device__ __forceinline__ void p0_item64(const float* W, int K, int N, bf16_t* WT, const float* gk, int plo, int phi, LAS float* scr, int item, int lane) {
    const int nblk = N / 64, kb = item / nblk, nb = item - kb * nblk, k0 = 64 * kb, n0 = 64 * nb;
    const int lr = lane >> 4, lc = lane & 15;
    f32x4 v[16];
#pragma unroll
    for (int i = 0; i < 16; ++i) v[i] = *(const f32x4*)(W + (size_t)(k0 + 4 * i + lr) * N + n0 + 4 * lc);
    if (gk) {
#pragma unroll
        for (int i = 0; i < 16; ++i) v[i] = v[i] * gk[k0 + 4 * i + lr];
    }
#pragma unroll
    for (int i = 0; i < 16; ++i) { LAS float* d = scr + (4 * i + lr) * 65 + 4 * lc; d[0] = v[i][0]; d[1] = v[i][1]; d[2] = v[i][2]; d[3] = v[i][3]; }
    asm volatile("s_waitcnt lgkmcnt(0)" ::: "memory");
    const bool perm = (n0 >= plo && n0 < phi); const int wc_ = (n0 & 255) >> 6;
    const int c = lane & 7;
#pragma unroll
    for (int j = 0; j < 8; ++j) { const int n = (lane >> 3) + 8 * j; const LAS float* sp = scr + (8 * c) * 65 + n;
        u32x4 o; o.x = cvt_pk_bf16(sp[0 * 65], sp[1 * 65]); o.y = cvt_pk_bf16(sp[2 * 65], sp[3 * 65]); o.z = cvt_pk_bf16(sp[4 * 65], sp[5 * 65]); o.w = cvt_pk_bf16(sp[6 * 65], sp[7 * 65]);
        const int drow = perm ? (n0 & ~255) + 128 * (n >> 5) + 32 * wc_ + (n & 31) : n0 + n;
        *(u32x4*)(WT + (size_t)drow * K + k0 + 8 * c) = o; }
    asm volatile("s_waitcnt lgkmcnt(0)" ::: "memory");
}
__device__ __forceinline__ void convert_layer(Frame& F, int l, int icu, int ncu) {
    LAS float* scr = (LAS float*)(F.lds + F.wave * P0_SCR);
    const int gw = icu * NWAVES + F.wave, NGW = ncu * NWAVES;
    constexpr int I_IN = (DM / 64) * (NCOLS / 64), I_SQ = (DM / 64) * (DM / 64), I_L = I_IN + 3 * I_SQ;
    unsigned char* wl = F.ws + WS_W + (size_t)l * W_LAYER;
    for (int it = gw; it < I_L; it += NGW) {
        int r = it;
        if (r < I_IN) { p0_item64(F.w_in + (size_t)l * DM * NCOLS, DM, NCOLS, (bf16_t*)wl, F.norm_g + l * DM, 4 * DM, 4 * DM + DM + KVW, scr, r, F.lane); continue; } r -= I_IN;
        if (r < I_SQ) { p0_item64(F.w_co + (size_t)l * DM * DM, DM, DM, (bf16_t*)(wl + W_CO), nullptr, 0, 0, scr, r, F.lane); continue; } r -= I_SQ;
        if (r < I_SQ) { p0_item64(F.w_ao + (size_t)l * DM * DM, DM, DM, (bf16_t*)(wl + W_AO), nullptr, 0, 0, scr, r, F.lane); continue; } r -= I_SQ;
        p0_item64(F.w_out + (size_t)l * DM * DM, DM, DM, (bf16_t*)(wl + W_OUT), nullptr, 0, 0, scr, r, F.lane);
    }
}
__device__ __forceinline__ void p0_prologue(Frame& F) {
    convert_layer(F, 0, F.vcu, F.G);
    const int gw = F.vcu * NWAVES + F.wave, NGW = F.G * NWAVES;
    float* rowss = (float*)(F.ws + WS_ROWSS); bf16_t* XB = (bf16_t*)(F.ws + WS_XB);
    for (int m = gw; m < M; m += NGW) {
        const f32x4* xr = (const f32x4*)(F.x + (size_t)m * DM) + F.lane; f32x4 v[4]; float s = 0.f;
#pragma unroll
        for (int j = 0; j < 4; ++j) { v[j] = xr[64 * j]; s += (v[j].x * v[j].x + v[j].y * v[j].y) + (v[j].z * v[j].z + v[j].w * v[j].w); }
        s = wave_sum(s);
        u32x2* o8 = (u32x2*)(XB + (size_t)m * DM) + F.lane;
#pragma unroll
        for (int j = 0; j < 4; ++j) { u32x2 w; w.x = cvt_pk_bf16(v[j].x, v[j].y); w.y = cvt_pk_bf16(v[j].z, v[j].w); o8[64 * j] = w; }
        if (F.lane == 0) rowss[m] = s;
        if (F.lane >= 1 && F.lane < DEPTH) rowss[(size_t)F.lane * M + m] = 0.f;
    }
}

__device__ __forceinline__ void conv_phase(Frame& F, int l) {
    const bf16_t* CVv = (const bf16_t*)(F.ws + WS_CV); const bf16_t* CVb = CVv + (size_t)M * DM; const bf16_t* CVc = CVb + (size_t)M * DM; const bf16_t* CVz = CVc + (size_t)M * DM;
    bf16_t* YC = (bf16_t*)(F.ws + WS_YC);
    const int cg8 = F.tid & 127, sub = F.tid >> 7;
    const float* cw = F.conv_w + (size_t)l * 3 * DM + cg8 * 8;
    float w0[8], w1[8], w2[8];
#pragma unroll
    for (int j = 0; j < 8; ++j) { w0[j] = cw[j]; w1[j] = cw[DM + j]; w2[j] = cw[2 * DM + j]; }
    for (int it = F.vcu; it < M / 64; it += F.G) {
        const int t0 = it * 64 + sub * 16; const size_t o0 = (size_t)t0 * DM + cg8 * 8;
        float p2[8], p1[8];
        if ((t0 & (SEQ - 1)) == 0) {
#pragma unroll
            for (int j = 0; j < 8; ++j) { p2[j] = 0.f; p1[j] = 0.f; }
        } else {
            const u32x4 va = *(const u32x4*)(CVv + o0 - 2 * DM), ca = *(const u32x4*)(CVc + o0 - 2 * DM), vb = *(const u32x4*)(CVv + o0 - DM), cb = *(const u32x4*)(CVc + o0 - DM);
#pragma unroll
            for (int j = 0; j < 4; ++j) { p2[2 * j] = bf_lo(va[j]) * bf_lo(ca[j]); p2[2 * j + 1] = bf_hi(va[j]) * bf_hi(ca[j]); p1[2 * j] = bf_lo(vb[j]) * bf_lo(cb[j]); p1[2 * j + 1] = bf_hi(vb[j]) * bf_hi(cb[j]); }
        }
#pragma unroll 4
        for (int t = 0; t < 16; ++t) {
            const size_t o = o0 + (size_t)t * DM;
            const u32x4 vv = *(const u32x4*)(CVv + o), cc = *(const u32x4*)(CVc + o), bb = *(const u32x4*)(CVb + o), zz = *(const u32x4*)(CVz + o);
            float y[8];
#pragma unroll
            for (int j = 0; j < 4; ++j) {
                const float c0 = bf_lo(vv[j]) * bf_lo(cc[j]), c1 = bf_hi(vv[j]) * bf_hi(cc[j]);
                const float z0 = bf_lo(zz[j]), z1 = bf_hi(zz[j]);
                y[2 * j] = bf_lo(bb[j]) * (w0[2 * j] * p2[2 * j] + w1[2 * j] * p1[2 * j] + w2[2 * j] * c0) * (z0 * fast_sigmoid(z0));
                y[2 * j + 1] = bf_hi(bb[j]) * (w0[2 * j + 1] * p2[2 * j + 1] + w1[2 * j + 1] * p1[2 * j + 1] + w2[2 * j + 1] * c1) * (z1 * fast_sigmoid(z1));
                p2[2 * j] = p1[2 * j]; p2[2 * j + 1] = p1[2 * j + 1]; p1[2 * j] = c0; p1[2 * j + 1] = c1;
            }
            u32x4 w; w.x = cvt_pk_bf16(y[0], y[1]); w.y = cvt_pk_bf16(y[2], y[3]); w.z = cvt_pk_bf16(y[4], y[5]); w.w = cvt_pk_bf16(y[6], y[7]);
            *(u32x4*)(YC + o) = w;
        }
    }
}

constexpr int KV_STRIDE = 160, KV_ROWS = 384, KV_IMG = KV_ROWS * KV_STRIDE;
__device__ __forceinline__ void attn_issue(const bf16_t* Qg, const bf16_t* SZ, const float* sinks, long qrow0, int hk, int it, int fq, bf16x8 (&q)[2], u32x2 (&sz)[4], float& sk) {
    const int rg = it >> 2, h = hk * 4 + (it & 3);
    const size_t ro = (size_t)(qrow0 + 128 * rg) * DM + h * HD;
    q[0] = *(const bf16x8*)(Qg + ro + 8 * fq); q[1] = *(const bf16x8*)(Qg + ro + 32 + 8 * fq);
#pragma unroll
    for (int dt = 0; dt < 4; ++dt) sz[dt] = *(const u32x2*)(SZ + ro + 16 * dt + 4 * fq);
    sk = sinks[h];
}
__device__ __forceinline__ void attn_phase(Frame& F, int l) {
    const bf16_t* Qg = (const bf16_t*)(F.ws + WS_Q); const bf16_t* Kg = (const bf16_t*)(F.ws + WS_K); const bf16_t* Vg = (const bf16_t*)(F.ws + WS_V);
    const bf16_t* SZ = (const bf16_t*)(F.ws + WS_SZ); bf16_t* OA = (bf16_t*)(F.ws + WS_OA);
    const float* sinks = F.sinks + l * NQH;
    LAS unsigned char* Kl = F.lds; LAS unsigned char* Vl = F.lds + KV_IMG;
    const int lane = F.lane, w = F.wave, fr = lane & 15, fq = lane >> 4;
    constexpr int NDU = BATCH * NKVH * (SEQ / 256);
    const float NEG = -INFINITY;
    for (int du = F.vcu; du < NDU; du += F.G) {
        const int n2 = du & 15, hk = (du >> 4) & 3, b = du >> 6;
        const long seq0 = (long)b * SEQ; const int band0 = 256 * n2 - 128;
        u32x4 kreg[6], vreg[6];
#pragma unroll
        for (int i = 0; i < 6; ++i) {
            const int idx = F.tid + 512 * i, r = idx >> 3, ch = idx & 7; int t = band0 + r; t = t < 0 ? 0 : t;
            const size_t go = (size_t)(seq0 + t) * KVW + hk * HD + ch * 8; kreg[i] = *(const u32x4*)(Kg + go); vreg[i] = *(const u32x4*)(Vg + go);
        }
        const long qrow0 = seq0 + 256 * n2 + 16 * w + fr;
        bf16x8 qc[2], qn[2]; u32x2 szc[4], szn[4]; float skc, skn;
        attn_issue(Qg, SZ, sinks, qrow0, hk, 0, fq, qn, szn, skn);
#pragma unroll
        for (int i = 0; i < 6; ++i) {
            const int idx = F.tid + 512 * i, r = idx >> 3, ch = idx & 7;
            *(LAS u32x4*)(Kl + r * KV_STRIDE + ch * 16) = kreg[i]; *(LAS u32x4*)(Vl + r * KV_STRIDE + ch * 16) = vreg[i];
        }
        __syncthreads();
        const int t9 = (w + 9 > 15 ? 15 : w + 9) - w;
#pragma unroll 1
        for (int it = 0; it < 8; ++it) {
            const int rg = it >> 2, h = hk * 4 + (it & 3);
            qc[0] = qn[0]; qc[1] = qn[1]; skc = skn;
#pragma unroll
            for (int dt = 0; dt < 4; ++dt) szc[dt] = szn[dt];
            attn_issue(Qg, SZ, sinks, qrow0, hk, it < 7 ? it + 1 : 7, fq, qn, szn, skn);
            const LAS unsigned char* kbase = Kl + (128 * rg + 16 * w + fr) * KV_STRIDE + 16 * fq;
            const LAS unsigned char* vbase = Vl + (128 * rg + 16 * w + 4 * fq + (fr >> 2)) * KV_STRIDE + 8 * (fr & 3);
            const float sink2 = skc * LOG2E;
            f32x4 st[9];
#pragma unroll
            for (int j = 0; j < 9; ++j) {
                const bf16x8 k0 = *(const LAS bf16x8*)(kbase + j * 16 * KV_STRIDE), k1 = *(const LAS bf16x8*)(kbase + j * 16 * KV_STRIDE + 64);
                f32x4 a = __builtin_amdgcn_mfma_f32_16x16x32_bf16(k0, qc[0], (f32x4){0.f, 0.f, 0.f, 0.f}, 0, 0, 0);
                st[j] = __builtin_amdgcn_mfma_f32_16x16x32_bf16(k1, qc[1], a, 0, 0, 0);
            }
#pragma unroll
            for (int i = 0; i < 4; ++i) { const int kk = 4 * fq + i; if (!(kk > fr)) st[0][i] = NEG; if (kk > fr) st[8][i] = NEG; }
            if (n2 == 0 && rg == 0) {
#pragma unroll
                for (int j = 0; j < 8; ++j) if (w + j < 8) st[j] = (f32x4){NEG, NEG, NEG, NEG};
            }
            float mx = sink2;
#pragma unroll
            for (int j = 0; j < 9; ++j) mx = fmaxf(mx, fmaxf(fmaxf(st[j][0], st[j][1]), fmaxf(st[j][2], st[j][3])));
            mx = fmaxf(mx, __shfl_xor(mx, 16)); mx = fmaxf(mx, __shfl_xor(mx, 32));
            float sum = 0.f;
#pragma unroll
            for (int j = 0; j < 9; ++j)
#pragma unroll
                for (int i = 0; i < 4; ++i) { st[j][i] = __builtin_amdgcn_exp2f(st[j][i] - mx); sum += st[j][i]; }
            sum += __shfl_xor(sum, 16); sum += __shfl_xor(sum, 32);
            const float inv = __builtin_amdgcn_rcpf(sum + __builtin_amdgcn_exp2f(sink2 - mx));
            f32x4 ot[4];
#pragma unroll
            for (int dt = 0; dt < 4; ++dt) ot[dt] = (f32x4){0.f, 0.f, 0.f, 0.f};
#pragma unroll
            for (int s5 = 0; s5 < 5; ++s5) {
                u32x4 pw;
                pw.x = cvt_pk_bf16(st[2 * s5][0], st[2 * s5][1]); pw.y = cvt_pk_bf16(st[2 * s5][2], st[2 * s5][3]);
                if (s5 < 4) { pw.z = cvt_pk_bf16(st[2 * s5 + 1][0], st[2 * s5 + 1][1]); pw.w = cvt_pk_bf16(st[2 * s5 + 1][2], st[2 * s5 + 1][3]); } else { pw.z = 0u; pw.w = 0u; }
                const bf16x8 pf = __builtin_bit_cast(bf16x8, pw);
                const int off0 = (2 * s5) * 16 * KV_STRIDE, off1 = (s5 < 4 ? (2 * s5 + 1) : t9) * 16 * KV_STRIDE;
#pragma unroll
                for (int dt = 0; dt < 4; ++dt) {
                    const s16x4 lo = __builtin_bit_cast(s16x4, __builtin_amdgcn_ds_read_tr16_b64_v4i16((LAS s16x4*)(vbase + off0 + 32 * dt)));
                    const s16x4 hi = __builtin_bit_cast(s16x4, __builtin_amdgcn_ds_read_tr16_b64_v4i16((LAS s16x4*)(vbase + off1 + 32 * dt)));
                    const bf16x8 vf = (bf16x8){lo[0], lo[1], lo[2], lo[3], hi[0], hi[1], hi[2], hi[3]};
                    ot[dt] = __builtin_amdgcn_mfma_f32_16x16x32_bf16(vf, pf, ot[dt], 0, 0, 0);
                }
            }
            bf16_t* op = OA + (size_t)(qrow0 + 128 * rg) * DM + h * HD + 4 * fq;
#pragma unroll
            for (int dt = 0; dt < 4; ++dt) {
                u32x2 o; o.x = cvt_pk_bf16(ot[dt][0] * inv * bf_lo(szc[dt].x), ot[dt][1] * inv * bf_hi(szc[dt].x)); o.y = cvt_pk_bf16(ot[dt][2] * inv * bf_lo(szc[dt].y), ot[dt][3] * inv * bf_hi(szc[dt].y));
                *(u32x2*)(op + 16 * dt) = o;
            }
        }
        __syncthreads();
    }
}

#define XB_TMO      128
#define XB_XCNT(j)  (256  + 64 * (j))
#define XB_XSUB(j)  (1280 + 64 * (j))
#define XB_XGEN(j)  (2304 + 64 * (j))
#define XB_TOP      3328
#define XB_TOPGEN   3392
#define XCD_BAR_WORDS 3456
#define XB_SPIN_CAP (1u << 18)
__device__ __forceinline__ unsigned xb_ld(unsigned* p)              { return __hip_atomic_load(p, __ATOMIC_RELAXED, __HIP_MEMORY_SCOPE_AGENT); }
__device__ __forceinline__ unsigned xb_add(unsigned* p, unsigned v) { return __hip_atomic_fetch_add(p, v, __ATOMIC_RELAXED, __HIP_MEMORY_SCOPE_AGENT); }
__device__ __forceinline__ unsigned xb_xcc_id() { return (unsigned)__builtin_amdgcn_s_getreg((3 << 11) | 20) & 0xFu; }
#define XB_SPIN(cond, bar) do { unsigned _sp = 0; while (cond) { __builtin_amdgcn_s_sleep(1); \
    if ((++_sp & 255u) == 0u) { if (xb_ld(&(bar)[XB_TMO])) break; if (_sp > XB_SPIN_CAP) { atomicAdd(&(bar)[XB_TMO], 1u); break; } } } } while (0)
struct XcdBarrier { unsigned* bar; unsigned x; volatile LAS unsigned* st; };
__device__ __forceinline__ XcdBarrier xcd_barrier_post(unsigned* bar, volatile LAS unsigned* st) {
    XcdBarrier b; b.bar = bar; b.x = xb_xcc_id(); b.st = st;
    if (threadIdx.x == 0) (void)xb_add(&bar[XB_XCNT(b.x)], 1u);
    return b;
}
__device__ __forceinline__ void xcd_barrier_complete(unsigned* bar, unsigned x, unsigned& nloc, unsigned& nx) {
    const unsigned G = gridDim.x * gridDim.y * gridDim.z;
    unsigned sum, cnt, mine, sp = 0u;
    for (;;) {
        sum = 0u; cnt = 0u; mine = 0u;
#pragma unroll
        for (unsigned j = 0; j < 16; ++j) { const unsigned c = xb_ld(&bar[XB_XCNT(j)]); sum += c; cnt += (c > 0u) ? 1u : 0u; mine = (j == x) ? c : mine; }
        if (sum == G) break;
        __builtin_amdgcn_s_sleep(1);
        if ((++sp & 255u) == 0u) { if (xb_ld(&bar[XB_TMO])) break; if (sp > XB_SPIN_CAP) { atomicAdd(&bar[XB_TMO], 1u); break; } }
    }
    nloc = mine > 0u ? mine : 1u; nx = cnt > 0u ? cnt : 1u;
}
__device__ __forceinline__ void xcd_barrier(const XcdBarrier& b) {
    asm volatile("s_waitcnt vmcnt(0)" ::: "memory");
    __syncthreads();
    if (threadIdx.x == 0) {
        unsigned* bar = b.bar;
        __builtin_amdgcn_s_waitcnt(0);
        unsigned nloc = b.st[0], nx = b.st[1];
        if (nloc == 0u) { xcd_barrier_complete(bar, b.x, nloc, nx); b.st[0] = nloc; b.st[1] = nx; }
        const unsigned old = xb_add(&bar[XB_XSUB(b.x)], 1u);
        const unsigned gen = old / nloc;
        if (old + 1u == (gen + 1u) * nloc) {
            __builtin_amdgcn_fence(__ATOMIC_RELEASE, "agent");
            asm volatile("s_waitcnt vmcnt(0)" ::: "memory");
            const unsigned og = xb_add(&bar[XB_TOP], 1u);
            const unsigned tg = og / nx;
            if (og + 1u == (tg + 1u) * nx) xb_add(&bar[XB_TOPGEN], 1u);
            else XB_SPIN(xb_ld(&bar[XB_TOPGEN]) == tg, bar);
            __builtin_amdgcn_fence(__ATOMIC_ACQUIRE, "agent");
            xb_add(&bar[XB_XGEN(b.x)], 1u);
            asm volatile("s_waitcnt vmcnt(0)" ::: "memory");
        } else {
            XB_SPIN(xb_ld(&bar[XB_XGEN(b.x)]) == gen, bar);
            __builtin_amdgcn_fence(__ATOMIC_ACQUIRE, "agent");
            asm volatile("s_waitcnt vmcnt(0)" ::: "memory");
        }
    }
    __syncthreads();
}

struct Args { const float* in[11]; float* out; unsigned char* ws; int ph_lo, ph_hi; };
constexpr int NPHASES = 1 + 4 * DEPTH;

__global__ void __launch_bounds__(NWAVES * 64, 2) fwd_kernel(Args args) {
    extern __shared__ __attribute__((aligned(16))) unsigned char lds_raw[];
    const int lo = args.ph_lo, hi = args.ph_hi;
    volatile LAS unsigned* MISC = (volatile LAS unsigned*)((LAS unsigned char*)lds_raw + LDS_BYTES - 128);
    if (threadIdx.x < 32) MISC[threadIdx.x] = 0u;
    __syncthreads();
    XcdBarrier bar = xcd_barrier_post((unsigned*)(args.ws + WS_CTL), MISC + 8);
    for (int ph = lo; ph < hi; ++ph) {
        if (ph > lo) { if (hi > NPHASES) cg::this_grid().sync(); else xcd_barrier(bar); }
        Frame F;
        F.lds = (LAS unsigned char*)lds_raw;
        { int t = threadIdx.x; asm volatile("" : "+v"(t)); F.tid = t; }
        F.lane = F.tid & 63; F.wave = __builtin_amdgcn_readfirstlane(F.tid >> 6);
        { int gsz = gridDim.x, bx = blockIdx.x; asm volatile("" : "+s"(gsz), "+s"(bx)); F.G = gsz; F.bx = bx; F.vcu = (F.G % 8 == 0) ? (bx % 8) * (F.G / 8) + bx / 8 : bx; }
        F.x = args.in[0]; F.norm_g = args.in[1]; F.w_in = args.in[2]; F.conv_w = args.in[3]; F.qng = args.in[4]; F.kng = args.in[5]; F.sinks = args.in[6];
        F.w_co = args.in[7]; F.w_ao = args.in[8]; F.gate_b = args.in[9]; F.w_out = args.in[10]; F.out = args.out;
        size_t wz = 0; asm volatile("" : "+s"(wz)); unsigned char* ws = args.ws + wz; F.ws = ws;
        float* rowss = (float*)(ws + WS_ROWSS);
        bf16_t* XB = (bf16_t*)(ws + WS_XB);
        if (ph == 0) { p0_prologue(F); if (PROBE_DUP & 1) p0_prologue(F); continue; }
        const int l = (ph - 1) >> 2, s = (ph - 1) & 3;
        unsigned char* wl = ws + WS_W + (size_t)l * W_LAYER;
        if (s == 0) {
            pg8::Gemm g{XB, (const bf16_t*)wl, XB, (const bf16_t*)wl, DM};
            pg8::StaticOrder S; S.init(M, NCOLS, F.G, F.bx, 1);
            EpiIn E{(bf16_t*)(ws + WS_CV), (bf16_t*)(ws + WS_Q), (bf16_t*)(ws + WS_K), (bf16_t*)(ws + WS_V), (bf16_t*)(ws + WS_SZ), (bf16_t*)(ws + WS_G),
                    rowss + (size_t)l * M, F.qng + l * HD, F.kng + l * HD, F.gate_b + l * 2 * DM};
            pg8::gemm_phase<EpiIn, true, true>(F.lds, F.tid, g, S, E);
            if (PROBE_DUP & 2) pg8::gemm_phase<EpiIn, true, true>(F.lds, F.tid, g, S, E);
            { const int rem = S.nwg % F.G; if (l + 1 < DEPTH && rem != 0 && F.bx >= rem) convert_layer(F, l + 1, F.bx - rem, F.G - rem); else if (l + 1 < DEPTH && rem == 0) convert_layer(F, l + 1, F.vcu, F.G); }
        } else if (s == 1) {
            attn_phase(F, l); if (PROBE_DUP & 4) attn_phase(F, l);
            conv_phase(F, l); if (PROBE_DUP & 8) conv_phase(F, l);
        } else if (s == 2) {
            pg8::Gemm g{(const bf16_t*)(ws + WS_YC), (const bf16_t*)(wl + W_CO), (const bf16_t*)(ws + WS_OA), (const bf16_t*)(wl + W_AO), DM};
            pg8::StaticOrder S; S.init(M, DM, F.G, F.bx, 2);
            EpiMerge E{(const bf16_t*)(ws + WS_G), (bf16_t*)(ws + WS_MG)};
            pg8::gemm_phase<EpiMerge, true, true>(F.lds, F.tid, g, S, E);
            if (PROBE_DUP & 16) pg8::gemm_phase<EpiMerge, true, true>(F.lds, F.tid, g, S, E);
        } else {
            pg8::Gemm g{(const bf16_t*)(ws + WS_MG), (const bf16_t*)(wl + W_OUT), (const bf16_t*)(ws + WS_MG), (const bf16_t*)(wl + W_OUT), DM};
            pg8::StaticOrder S; S.init(M, DM, F.G, F.bx, 1);
            const bool lastl = (l == DEPTH - 1);
            EpiOut E{l == 0 ? F.x : F.out, F.out, XB, lastl ? nullptr : rowss + (size_t)(l + 1) * M};
            if (PROBE_DUP & 32) { EpiOut E2{l == 0 ? F.x : F.out, (float*)(ws + WS_CV), XB, nullptr}; pg8::gemm_phase<EpiOut, true, true>(F.lds, F.tid, g, S, E2); }
            pg8::gemm_phase<EpiOut, true, true>(F.lds, F.tid, g, S, E);
        }
    }
}

extern "C" void kernel_launch(void* const* d_in, const int* in_sizes, int n_in, void* d_out, int out_size, void* d_ws, size_t ws_size, hipStream_t stream) {
    static int grid = 0;
    if (grid == 0) {
        if (n_in != 11 || in_sizes[0] != M * DM || out_size != M * DM || ws_size < WS_END) {
            fprintf(stderr, "kernel_launch: unexpected shapes: n_in %d in0 %d out %d ws %zu (need %zu)\n", n_in, n_in > 0 ? in_sizes[0] : -1, out_size, ws_size, (size_t)WS_END); grid = -1; return; }
        int dev = 0, cus = 0, per_cu = 0;
        hipGetDevice(&dev); hipDeviceGetAttribute(&cus, hipDeviceAttributeMultiprocessorCount, dev);
        if (hipFuncSetAttribute((const void*)fwd_kernel, hipFuncAttributeMaxDynamicSharedMemorySize, LDS_BYTES) != hipSuccess) { fprintf(stderr, "kernel_launch: hipFuncSetAttribute failed\n"); grid = -1; return; }
        if (hipOccupancyMaxActiveBlocksPerMultiprocessor(&per_cu, (const void*)fwd_kernel, NWAVES * 64, LDS_BYTES) != hipSuccess || per_cu < 1) { fprintf(stderr, "kernel_launch: occupancy query says %d\n", per_cu); per_cu = 1; }
        (void)hipGetLastError();
        grid = cus * 1;
        fprintf(stderr, "kernel_launch: grid %d (cus %d, per_cu %d)\n", grid, cus, per_cu);
    }
    if (grid < 0) return;
    Args a{};
    for (int i = 0; i < 11; ++i) a.in[i] = (const float*)d_in[i];
    a.out = (float*)d_out; a.ws = (unsigned char*)d_ws;
    if (hipMemsetAsync((char*)d_ws + WS_CTL, 0, CTL_BYTES, stream) != hipSuccess) { fprintf(stderr, "kernel_launch: memset failed\n"); return; }
#if MK_ONE_LAUNCH
    a.ph_lo = 0; a.ph_hi = NPHASES;
    void* kargs[] = {&a};
    hipError_t e = hipLaunchCooperativeKernel((const void*)fwd_kernel, dim3(grid), dim3(NWAVES * 64), kargs, LDS_BYTES, stream);
    if (e != hipSuccess) fprintf(stderr, "kernel_launch: cooperative launch failed: %s (grid %d)\n", hipGetErrorString(e), grid);
#else
    for (int p = 0; p < NPHASES; ++p) { a.ph_lo = p; a.ph_hi = p + 1; hipLaunchKernelGGL(fwd_kernel, dim3(grid), dim3(NWAVES * 64), LDS_BYTES, stream, a); }
#endif
}
```
